# Optimizing an MI355X kernel written in HIP

```python
import math
import jax
import jax.numpy as jnp
from jax import lax
import numpy as np

D_MODEL = 1024
BATCH = 16
SEQ = 256
DEPTH = 1
DEC_BATCH = 8
DEC_SEQ = 4096
PAST_LEN = 512

GRID_W = 64
N_HEADS = 16
N_KV_HEADS = 4
HEAD_DIM = D_MODEL // N_HEADS
GQA_GROUP = N_HEADS // N_KV_HEADS
WINDOW = 128
BLOCK = 128
ROPE_BASE = 10000.0
D_HYENA = D_MODEL
HYENA_ORDER = 2
N_BANDS = 16
FILTER_EMB = 1 + 2 * N_BANDS
FILTER_WIDTH = 64
DECAY_MIN = math.log(100.0) / 1.5
DECAY_MAX = math.log(100.0) / 0.3
D_FF = 2816
N_MOD = 9
EPS = 1e-6
NEG_INF = -1e30

Q_COLS = N_HEADS * HEAD_DIM
KV_COLS = N_KV_HEADS * HEAD_DIM
HY_COLS = 3 * D_HYENA
GATE_COLS = 2 * D_MODEL
IN_COLS = Q_COLS + 2 * KV_COLS + HY_COLS + GATE_COLS
SPLIT_AT = (Q_COLS, Q_COLS + KV_COLS, Q_COLS + 2 * KV_COLS, Q_COLS + 2 * KV_COLS + HY_COLS)

kernel_name = 'hybrid_hyena_swa_dit_step'


def _rmsnorm(x, g):
    x32 = x.astype(jnp.float32)
    y = x32 * lax.rsqrt(jnp.mean(x32 * x32, axis=-1, keepdims=True) + EPS)
    return (y * g.astype(jnp.float32)).astype(x.dtype)


def _modulate(h, shift, scale):
    return h * (1.0 + scale) + shift


def _swiglu(h, w_gate_up, w_down):
    gate, up = jnp.split(h @ w_gate_up, 2, axis=-1)
    return (jax.nn.silu(gate) * up) @ w_down


def _axial_rope(x):
    n = x.shape[1]
    rows = n // GRID_W
    row = jnp.repeat(jnp.arange(rows), GRID_W)
    col = jnp.tile(jnp.arange(GRID_W), rows)
    n_freq = HEAD_DIM // 4
    inv = ROPE_BASE ** (-jnp.arange(n_freq, dtype=jnp.float32) / n_freq)

    def rot(xh, pos):
        ang = pos.astype(jnp.float32)[:, None] * inv[None, :]
        cos = jnp.cos(ang)[None, :, None, :]
        sin = jnp.sin(ang)[None, :, None, :]
        x1, x2 = jnp.split(xh.astype(jnp.float32), 2, axis=-1)
        return jnp.concatenate([x1 * cos - x2 * sin, x2 * cos + x1 * sin], axis=-1)

    xr, xc = jnp.split(x, 2, axis=-1)
    return jnp.concatenate([rot(xr, row), rot(xc, col)], axis=-1).astype(x.dtype)


def _attend(q, k, v, mask, sink):
    s = jnp.einsum('bqhgd,bkhd->bhgqk', q, k).astype(jnp.float32) * (1.0 / math.sqrt(HEAD_DIM))
    if mask is not None:
        s = jnp.where(mask, s, NEG_INF)
    sink_col = jnp.broadcast_to(sink.astype(jnp.float32).reshape(1, N_KV_HEADS, GQA_GROUP, 1, 1), s.shape[:-1] + (1,))
    p = jax.nn.softmax(jnp.concatenate([sink_col, s], axis=-1), axis=-1)[..., 1:]
    return jnp.einsum('bhgqk,bkhd->bqhgd', p.astype(v.dtype), v)


def _context_attention(q, k, v, sink):
    b, s_len = q.shape[:2]
    nb = s_len // BLOCK
    qb = q.reshape(b, nb, BLOCK, N_KV_HEADS, GQA_GROUP, HEAD_DIM)

    def block(i):
        qi = lax.dynamic_index_in_dim(qb, i, axis=1, keepdims=False)
        return _attend(qi, k, v, None, sink)

    o = lax.map(block, jnp.arange(nb))
    return jnp.moveaxis(o, 0, 1).reshape(b, s_len, Q_COLS)


def _latent_attention(q, k, v, ck, cv, sink):
    b, n = q.shape[:2]
    nb = n // BLOCK
    p_len = ck.shape[1]
    qb = q.reshape(b, nb, BLOCK, N_KV_HEADS, GQA_GROUP, HEAD_DIM)
    pad = ((0, 0), (BLOCK, BLOCK), (0, 0), (0, 0))
    kp = jnp.pad(k, pad)
    vp = jnp.pad(v, pad)
    ctx_mask = jnp.ones((BLOCK, p_len), dtype=bool)

    def block(i):
        qi = lax.dynamic_index_in_dim(qb, i, axis=1, keepdims=False)
        kw = lax.dynamic_slice_in_dim(kp, i * BLOCK, 3 * BLOCK, axis=1)
        vw = lax.dynamic_slice_in_dim(vp, i * BLOCK, 3 * BLOCK, axis=1)
        qpos = i * BLOCK + jnp.arange(BLOCK)
        kpos = (i - 1) * BLOCK + jnp.arange(3 * BLOCK)
        band = (jnp.abs(qpos[:, None] - kpos[None, :]) <= WINDOW) & (kpos[None, :] >= 0) & (kpos[None, :] < n)
        mask = jnp.concatenate([ctx_mask, band], axis=1)
        keys = jnp.concatenate([ck, kw], axis=1)
        vals = jnp.concatenate([cv, vw], axis=1)
        return _attend(qi, keys, vals, mask, sink)

    o = lax.map(block, jnp.arange(nb))
    return jnp.moveaxis(o, 0, 1).reshape(b, n, Q_COLS)


def _short_conv(u, w, bias):
    up = jnp.pad(u, ((0, 0), (1, 1), (0, 0)))
    return up[:, :-2] * w[0] + up[:, 1:-1] * w[1] + up[:, 2:] * w[2] + bias


def _hyena_filters_rfft(n, p):
    t = jnp.arange(n, dtype=jnp.float32) / max(n - 1, 1)
    bands = jnp.arange(1, N_BANDS + 1, dtype=jnp.float32)
    ang = 2.0 * math.pi * t[:, None] * bands[None, :]
    z = jnp.concatenate([t[:, None], jnp.cos(ang), jnp.sin(ang)], axis=-1)
    freq = p['filt_freq'].astype(jnp.float32)
    h = jnp.sin(freq * (z @ p['filt_w1'].astype(jnp.float32) + p['filt_b1'].astype(jnp.float32)))
    h = jnp.sin(freq * (h @ p['filt_w2'].astype(jnp.float32) + p['filt_b2'].astype(jnp.float32)))
    h = (h @ p['filt_w3'].astype(jnp.float32) + p['filt_b3'].astype(jnp.float32)).reshape(n, HYENA_ORDER, 2, D_HYENA)
    h = h * jnp.exp(-t[:, None, None, None] * jnp.abs(p['filt_decay'].astype(jnp.float32))[None])
    h = h / (jnp.sum(jnp.abs(h), axis=(0, 2), keepdims=True) + EPS)
    fwd = h[:, :, 0]
    bwd = h[:, :, 1]
    circ = jnp.concatenate([fwd, jnp.zeros_like(fwd[:1]), bwd[1:][::-1]], axis=0)
    return jnp.fft.rfft(circ, axis=0)


def _fftconv(z, kf, skip):
    n = z.shape[1]
    zf = jnp.fft.rfft(z, n=2 * n, axis=1)
    y = jnp.fft.irfft(zf * kf[None], n=2 * n, axis=1)[:, :n]
    return y + z * skip


def _hyena(u, p):
    n = u.shape[1]
    u32 = _short_conv(u, p['conv_w'], p['conv_b']).astype(jnp.float32)
    x1, x2, v = jnp.split(u32, 3, axis=-1)
    kf = _hyena_filters_rfft(n, p)
    skip = p['hyena_skip'].astype(jnp.float32)
    z = x1 * _fftconv(v, kf[:, 0], skip[0])
    z = x2 * _fftconv(z, kf[:, 1], skip[1])
    return z.astype(u.dtype)


def _layer(x, mod, p, ctx_kv):
    sh1, sc1, g1, sh2, sc2, g2, sh3, sc3, g3 = jnp.split(mod, N_MOD, axis=-1)
    h = _modulate(_rmsnorm(x, p['norm_ffn1']), sh1, sc1)
    x = x + 0.5 * g1 * _swiglu(h, p['ffn1_wi'], p['ffn1_wo'])

    h = _modulate(_rmsnorm(x, p['norm_mix']), sh2, sc2)
    b, n = h.shape[:2]
    q, k, v, hy_in, gates = jnp.split(h @ p['w_in'], SPLIT_AT, axis=-1)
    q = _rmsnorm(q.reshape(b, n, N_HEADS, HEAD_DIM), p['q_norm'])
    k = _rmsnorm(k.reshape(b, n, N_KV_HEADS, HEAD_DIM), p['k_norm'])
    v = v.reshape(b, n, N_KV_HEADS, HEAD_DIM)
    if ctx_kv is None:
        attn = _context_attention(q, k, v, p['attn_sink'])
        state = (k, v)
    else:
        attn = _latent_attention(_axial_rope(q), _axial_rope(k), v, ctx_kv[0], ctx_kv[1], p['attn_sink'])
        state = None
    hy = _hyena(hy_in, p)
    gate_a, gate_h = jnp.split(gates, 2, axis=-1)
    merged = jax.nn.sigmoid(gate_a) * (attn @ p['w_attn_branch']) + jax.nn.sigmoid(gate_h) * (hy @ p['w_hyena_branch'])
    x = x + g2 * (merged @ p['w_out'])

    h = _modulate(_rmsnorm(x, p['norm_ffn2']), sh3, sc3)
    x = x + 0.5 * g3 * _swiglu(h, p['ffn2_wi'], p['ffn2_wo'])
    return x, state


def _nrm(k, shape, scale=1.0):
    return scale * jax.random.normal(k, shape, jnp.float32)


def setup_inputs(seed: int = 0) -> dict:
    key = jax.random.key(seed)
    k = jax.random.split(key, 33)
    decay0 = jnp.broadcast_to(jnp.linspace(DECAY_MIN, DECAY_MAX, D_HYENA, dtype=jnp.float32), (DEPTH, HYENA_ORDER, 2, D_HYENA))
    return {
        'x_prompt': _nrm(k[0], (BATCH, SEQ, D_MODEL)),
        'x_sample': _nrm(k[1], (DEC_BATCH, DEC_SEQ, D_MODEL)),
        'cache_k': _nrm(k[2], (DEC_BATCH, DEPTH, PAST_LEN, N_KV_HEADS, HEAD_DIM)),
        'cache_v': _nrm(k[3], (DEC_BATCH, DEPTH, PAST_LEN, N_KV_HEADS, HEAD_DIM)),
        'c': _nrm(k[4], (DEC_BATCH, D_MODEL)),
        'c_ctx': _nrm(k[5], (D_MODEL,)),
        'w_mod': _nrm(k[6], (DEPTH, D_MODEL, N_MOD * D_MODEL), D_MODEL ** -0.5),
        'b_mod': _nrm(k[7], (DEPTH, N_MOD * D_MODEL), 0.02),
        'norm_ffn1': 1.0 + _nrm(k[8], (DEPTH, D_MODEL), 0.02),
        'ffn1_wi': _nrm(k[9], (DEPTH, D_MODEL, 2 * D_FF), D_MODEL ** -0.5),
        'ffn1_wo': _nrm(k[10], (DEPTH, D_FF, D_MODEL), D_FF ** -0.5),
        'norm_mix': 1.0 + _nrm(k[11], (DEPTH, D_MODEL), 0.02),
        'w_in': _nrm(k[12], (DEPTH, D_MODEL, IN_COLS), D_MODEL ** -0.5),
        'q_norm': 1.0 + _nrm(k[13], (DEPTH, HEAD_DIM), 0.02),
        'k_norm': 1.0 + _nrm(k[14], (DEPTH, HEAD_DIM), 0.02),
        'attn_sink': _nrm(k[15], (DEPTH, N_HEADS), 0.5),
        'conv_w': _nrm(k[16], (DEPTH, 3, HY_COLS), 3.0 ** -0.5),
        'conv_b': _nrm(k[17], (DEPTH, HY_COLS), 0.01),
        'filt_w1': _nrm(k[18], (DEPTH, FILTER_EMB, FILTER_WIDTH), FILTER_EMB ** -0.5),
        'filt_b1': _nrm(k[19], (DEPTH, FILTER_WIDTH), 0.02),
        'filt_w2': _nrm(k[20], (DEPTH, FILTER_WIDTH, FILTER_WIDTH), FILTER_WIDTH ** -0.5),
        'filt_b2': _nrm(k[21], (DEPTH, FILTER_WIDTH), 0.02),
        'filt_w3': _nrm(k[22], (DEPTH, FILTER_WIDTH, HYENA_ORDER * 2 * D_HYENA), FILTER_WIDTH ** -0.5),
        'filt_b3': _nrm(k[23], (DEPTH, HYENA_ORDER * 2 * D_HYENA), 0.02),
        'filt_freq': 1.0 + _nrm(k[24], (DEPTH, FILTER_WIDTH), 0.02),
        'filt_decay': decay0 + _nrm(k[25], (DEPTH, HYENA_ORDER, 2, D_HYENA), 0.1),
        'hyena_skip': _nrm(k[26], (DEPTH, HYENA_ORDER, D_HYENA), 0.1),
        'w_attn_branch': _nrm(k[27], (DEPTH, Q_COLS, D_MODEL), Q_COLS ** -0.5),
        'w_hyena_branch': _nrm(k[28], (DEPTH, D_HYENA, D_MODEL), D_HYENA ** -0.5),
        'w_out': _nrm(k[29], (DEPTH, D_MODEL, D_MODEL), D_MODEL ** -0.5),
        'norm_ffn2': 1.0 + _nrm(k[30], (DEPTH, D_MODEL), 0.02),
        'ffn2_wi': _nrm(k[31], (DEPTH, D_MODEL, 2 * D_FF), D_MODEL ** -0.5),
        'ffn2_wo': _nrm(k[32], (DEPTH, D_FF, D_MODEL), D_FF ** -0.5),
    }


def reference(x_prompt, x_sample, cache_k, cache_v, c, c_ctx, w_mod, b_mod, norm_ffn1, ffn1_wi, ffn1_wo,
              norm_mix, w_in, q_norm, k_norm, attn_sink, conv_w, conv_b, filt_w1, filt_b1, filt_w2, filt_b2,
              filt_w3, filt_b3, filt_freq, filt_decay, hyena_skip, w_attn_branch, w_hyena_branch, w_out,
              norm_ffn2, ffn2_wi, ffn2_wo):
    y_prompt = x_prompt
    y_sample = x_sample
    new_ks = []
    new_vs = []
    for l in range(DEPTH):
        p = {
            'norm_ffn1': norm_ffn1[l], 'ffn1_wi': ffn1_wi[l], 'ffn1_wo': ffn1_wo[l],
            'norm_mix': norm_mix[l], 'w_in': w_in[l], 'q_norm': q_norm[l], 'k_norm': k_norm[l],
            'attn_sink': attn_sink[l], 'conv_w': conv_w[l], 'conv_b': conv_b[l],
            'filt_w1': filt_w1[l], 'filt_b1': filt_b1[l], 'filt_w2': filt_w2[l], 'filt_b2': filt_b2[l],
            'filt_w3': filt_w3[l], 'filt_b3': filt_b3[l], 'filt_freq': filt_freq[l], 'filt_decay': filt_decay[l],
            'hyena_skip': hyena_skip[l], 'w_attn_branch': w_attn_branch[l], 'w_hyena_branch': w_hyena_branch[l],
            'w_out': w_out[l], 'norm_ffn2': norm_ffn2[l], 'ffn2_wi': ffn2_wi[l], 'ffn2_wo': ffn2_wo[l],
        }
        mod_ctx = jax.nn.silu(c_ctx) @ w_mod[l] + b_mod[l]
        mod_lat = (jax.nn.silu(c) @ w_mod[l] + b_mod[l])[:, None, :]
        y_prompt, (k_ctx, v_ctx) = _layer(y_prompt, mod_ctx, p, None)
        y_sample, _ = _layer(y_sample, mod_lat, p, (cache_k[:, l], cache_v[:, l]))
        new_ks.append(k_ctx)
        new_vs.append(v_ctx)
    new_k = jnp.stack(new_ks, axis=1)
    new_v = jnp.stack(new_vs, axis=1)
    return (y_prompt, y_sample, new_k, new_v)
```

```cpp
#include <hip/hip_runtime.h>
#include <cstdio>
#include <cstdint>

#ifndef REPMASK
#define REPMASK 0
#endif
#ifndef DRY_AT
#define DRY_AT 0
#endif
#ifndef DRY_HY
#define DRY_HY 0
#endif
#ifndef DRY_NOCONV
#define DRY_NOCONV 0
#endif
#ifndef HY_FFT
#define HY_FFT 1
#endif
#ifndef FAST_ATTN
#define FAST_ATTN 1
#endif
#ifndef FAST_HYENA
#define FAST_HYENA 1
#endif
#ifndef FASTMASK
#define FASTMASK 0x6F6C
#endif
#ifndef MK_ONE_LAUNCH
#define MK_ONE_LAUNCH 1
#endif

#define GAS __attribute__((address_space(1)))
#define LAS __attribute__((address_space(3)))
typedef unsigned short bf16;
typedef short bf16x8 __attribute__((ext_vector_type(8)));
typedef float f32x4 __attribute__((ext_vector_type(4)));
typedef float f32x16 __attribute__((ext_vector_type(16)));
typedef unsigned u32x4 __attribute__((ext_vector_type(4)));
typedef unsigned u32x2 __attribute__((ext_vector_type(2)));

constexpr int DM = 1024, NCTX = 16 * 256, NLAT = 8 * 4096, MTOK = NCTX + NLAT, DFF = 2816, NMODV = 9, MODW = 9 * DM;
constexpr int LSEQ = 4096, CSEQ = 256, NH = 16, NKV = 4, HD = 64, KVW = NKV * HD, PAST = 512, WIN = 128;
constexpr int INCOLS = 6656, NQKV = 1536, NHY = 3072, NGATE = 2048;
constexpr int FW = 64, FEMB = 33;
constexpr float EPSF = 1e-6f;
constexpr int KLPAD = 192, KLROWS = PAST + LSEQ + KLPAD;

constexpr size_t MiB = 1u << 20;
constexpr size_t WS_CTL = 0, CTL_ZERO_BYTES = 1 * MiB;
constexpr size_t WS_MOD = 1 * MiB;
constexpr size_t WS_H2 = 2 * MiB;
constexpr size_t WS_INVS = 4 * MiB;
constexpr size_t WS_ROPE = 5 * MiB;
constexpr size_t WS_WI1 = 10 * MiB, WS_WO1 = 21 * MiB, WS_WQKV = 27 * MiB, WS_WHY = 30 * MiB, WS_WG = 36 * MiB, WS_WA = 40 * MiB, WS_WH = 42 * MiB,
                 WS_WOUT = 44 * MiB, WS_WI2 = 46 * MiB, WS_WO2 = 57 * MiB;
constexpr size_t WS_KS = WS_WI1;
constexpr size_t WS_TAPL = 63 * MiB;
constexpr size_t WS_TAPC = 95 * MiB;
constexpr size_t WS_A = 97 * MiB;
constexpr size_t WS_U = 169 * MiB;
constexpr size_t WS_Q = 169 * MiB;
constexpr size_t WS_KC = 241 * MiB, WS_KL = 243 * MiB, WS_VC = 262 * MiB, WS_VL = 264 * MiB;
constexpr size_t WS_HYT = 283 * MiB;
constexpr size_t WS_HYO = WS_HYT + 72 * MiB;
constexpr size_t WS_GH = WS_HYT + 144 * MiB;
constexpr size_t WS_MA = WS_A, WS_A3 = WS_GH;
constexpr size_t WS_END = WS_HYT + 216 * MiB;
static_assert(WS_END <= 512 * MiB, "ws map");
constexpr size_t OUT_NK = (size_t)MTOK * DM, OUT_NV = OUT_NK + (size_t)NCTX * KVW;

constexpr int NWAVES = 8, NTHR = 512;
constexpr int LDS_BYTES = 163840;

__device__ __forceinline__ unsigned f2bf(float f) { unsigned u = __builtin_bit_cast(unsigned, f); return (u + 0x7fffu + ((u >> 16) & 1u)) >> 16; }
__device__ __forceinline__ float bf2f(unsigned b) { return __builtin_bit_cast(float, b << 16); }
__device__ __forceinline__ unsigned pk2(float lo, float hi) { return f2bf(lo) | (f2bf(hi) << 16); }
__device__ __forceinline__ float sigmoidf_(float x) { return 1.0f / (1.0f + __expf(-x)); }
__device__ __forceinline__ float wave_sum(float v) {
#pragma unroll
    for (int o = 1; o < 64; o <<= 1) v += __shfl_xor(v, o);
    return v;
}
#define LDS_WAIT() asm volatile("s_waitcnt lgkmcnt(0)" ::: "memory")
#define VM_WAIT() asm volatile("s_waitcnt vmcnt(0)" ::: "memory")

__host__ __device__ __forceinline__ int map_swiglu(int n) { const int bj = n / DFF, j = n % DFF; return 256 * (j / 128) + 128 * bj + (j % 128); }
__host__ __device__ __forceinline__ int map_qkv(int n) {
    if (n < 1024) { const int h = n / 64, d = n % 64; return 256 * (h / 4) + 128 * (d / 32) + 32 * (h % 4) + (d % 32); }
    if (n < 1280) { const int h = (n - 1024) / 64, d = n % 64; return 1024 + 128 * (d / 32) + 32 * h + (d % 32); }
    return n;
}
__device__ __forceinline__ int mod_row(int m) { return m < NCTX ? 0 : 1 + ((m - NCTX) >> 12); }

struct Args { const float* in[33]; float* out; unsigned char* ws; int ph_lo, ph_hi, li, pad; };
struct Frame {
    LAS unsigned char* lds;
    int tid, lane, wave, G, bid;
    float* out; unsigned char* ws;
};
#define WSP(T, off) ((T*)(F.ws + (off)))
enum { I_XP = 0, I_XS, I_CK, I_CV, I_C, I_CCTX, I_WMOD, I_BMOD, I_NF1, I_WI1, I_WO1, I_NMIX, I_WIN, I_QN, I_KN, I_SINK, I_CW, I_CB, I_FW1, I_FB1, I_FW2, I_FB2, I_FW3, I_FB3,
       I_FFREQ, I_FDEC, I_HSKIP, I_WA, I_WH, I_WOUT, I_NF2, I_WI2, I_WO2 };

__device__ __forceinline__ void p0_mod(const Args& args, Frame& F) {
    LAS float* sv = (LAS float*)F.lds;
    LAS float* red = sv + 9 * 1024;
    bool have = false;
    for (int u = F.bid; u < MODW / 32; u += F.G) {
        if (!have) {
            for (int i = F.tid; i < 9 * 1024; i += NTHR) { const float c = (i < 1024) ? args.in[I_CCTX][i] : args.in[I_C][i - 1024]; sv[i] = c / (1.0f + __expf(-c)); }
            have = true; __syncthreads();
        }
        const int nn = F.tid & 31, kp = F.tid >> 5, n = u * 32 + nn;
        float acc[9];
#pragma unroll
        for (int i = 0; i < 9; ++i) acc[i] = 0.f;
        const float* w = args.in[I_WMOD] + (size_t)(kp * 64) * MODW + n;
#pragma unroll 1
        for (int k0 = 0; k0 < 64; k0 += 16) { float wv[16];
#pragma unroll
            for (int k = 0; k < 16; ++k) wv[k] = w[(size_t)(k0 + k) * MODW];
#pragma unroll
            for (int k = 0; k < 16; ++k)
#pragma unroll
                for (int i = 0; i < 9; ++i) acc[i] += sv[i * 1024 + kp * 64 + k0 + k] * wv[k]; }
#pragma unroll
        for (int i = 0; i < 9; ++i) red[(kp * 9 + i) * 32 + nn] = acc[i];
        __syncthreads();
        for (int e = F.tid; e < 9 * 32; e += NTHR) { const int i = e / 32, n2 = e % 32; float s = args.in[I_BMOD][u * 32 + n2];
#pragma unroll
            for (int k = 0; k < 16; ++k) s += red[(k * 9 + i) * 32 + n2];
            WSP(float, WS_MOD)[i * MODW + u * 32 + n2] = s; }
        __syncthreads();
    }
}
template <int MAP> __device__ __forceinline__ void transpose_item(const float* W, int ldw, int col0, int K, int ncols, bf16* WT, LAS float* scr, int item, int lane) {
    const int nblk = ncols / 32, kb = item / nblk, nb = item % nblk, k0 = 64 * kb, n0 = 32 * nb;
    float tv[32];
#pragma unroll
    for (int i = 0; i < 32; ++i) { const int kk = 2 * i + (lane >> 5); tv[i] = W[(size_t)(k0 + kk) * ldw + col0 + n0 + (lane & 31)]; }
#pragma unroll
    for (int i = 0; i < 32; ++i) { const int kk = 2 * i + (lane >> 5); scr[kk * 33 + (lane & 31)] = tv[i]; }
    LDS_WAIT(); asm volatile("" ::: "memory");
    const int c = lane & 7;
#pragma unroll
    for (int j = 0; j < 4; ++j) { const int n = (lane >> 3) + 8 * j; const LAS float* s = scr + (8 * c) * 33 + n;
        u32x4 o; o.x = pk2(s[0 * 33], s[1 * 33]); o.y = pk2(s[2 * 33], s[3 * 33]); o.z = pk2(s[4 * 33], s[5 * 33]); o.w = pk2(s[6 * 33], s[7 * 33]);
        const int nn = n0 + n, row = MAP == 1 ? map_swiglu(nn) : MAP == 2 ? map_qkv(nn) : nn;
        *(u32x4*)(WT + (size_t)row * K + k0 + 8 * c) = o; }
    LDS_WAIT(); asm volatile("" ::: "memory");
}
__device__ __forceinline__ void p0_weights(const Args& args, Frame& F) {
    LAS float* scr = (LAS float*)(F.lds + 65536 + F.wave * 8704);
    const int gw = F.bid * NWAVES + F.wave, NGW = F.G * NWAVES;
    constexpr int I_A = 16 * 176, I_B = 44 * 32, I_C3 = 16 * 48, I_D = 16 * 96, I_E = 16 * 64, I_S = 16 * 32;
    constexpr int NITEMS = 2 * I_A + 2 * I_B + I_C3 + I_D + I_E + 3 * I_S;
    for (int it = gw; it < NITEMS; it += NGW) {
        int r = it;
        if (r < I_A) { transpose_item<1>(args.in[I_WI1], 2 * DFF, 0, DM, 2 * DFF, WSP(bf16, WS_WI1), scr, r, F.lane); continue; } r -= I_A;
        if (r < I_A) { transpose_item<1>(args.in[I_WI2], 2 * DFF, 0, DM, 2 * DFF, WSP(bf16, WS_WI2), scr, r, F.lane); continue; } r -= I_A;
        if (r < I_B) { transpose_item<0>(args.in[I_WO1], DM, 0, DFF, DM, WSP(bf16, WS_WO1), scr, r, F.lane); continue; } r -= I_B;
        if (r < I_B) { transpose_item<0>(args.in[I_WO2], DM, 0, DFF, DM, WSP(bf16, WS_WO2), scr, r, F.lane); continue; } r -= I_B;
        if (r < I_C3) { transpose_item<2>(args.in[I_WIN], INCOLS, 0, DM, NQKV, WSP(bf16, WS_WQKV), scr, r, F.lane); continue; } r -= I_C3;
        if (r < I_D) { transpose_item<0>(args.in[I_WIN], INCOLS, NQKV, DM, NHY, WSP(bf16, WS_WHY), scr, r, F.lane); continue; } r -= I_D;
        if (r < I_E) { transpose_item<0>(args.in[I_WIN], INCOLS, NQKV + NHY, DM, NGATE, WSP(bf16, WS_WG), scr, r, F.lane); continue; } r -= I_E;
        if (r < I_S) { transpose_item<0>(args.in[I_WA], DM, 0, DM, DM, WSP(bf16, WS_WA), scr, r, F.lane); continue; } r -= I_S;
        if (r < I_S) { transpose_item<0>(args.in[I_WH], DM, 0, DM, DM, WSP(bf16, WS_WH), scr, r, F.lane); continue; } r -= I_S;
        transpose_item<0>(args.in[I_WOUT], DM, 0, DM, DM, WSP(bf16, WS_WOUT), scr, r, F.lane);
    }
}
__device__ __forceinline__ void p0_h2(const Args& args, Frame& F) {
    const int gw = F.bid * NWAVES + F.wave, NGW = F.G * NWAVES, lane = F.lane;
    const float* w1 = args.in[I_FW1]; const float* w2 = args.in[I_FW2];
    const float fr = args.in[I_FFREQ][lane], b1 = args.in[I_FB1][lane], b2 = args.in[I_FB2][lane];
    for (int row = gw; row < LSEQ + CSEQ; row += NGW) {
        const float tt = row < LSEQ ? (float)row / (float)(LSEQ - 1) : (float)(row - LSEQ) / (float)(CSEQ - 1);
        float zv = 0.f;
        if (lane == 0) zv = tt;
        else if (lane <= 16) zv = cosf(6.283185307179586f * tt * (float)lane);
        else if (lane <= 32) zv = sinf(6.283185307179586f * tt * (float)(lane - 16));
        float a = b1;
        for (int e = 0; e < FEMB; ++e) a += __shfl(zv, e) * w1[e * FW + lane];
        const float h1 = sinf(fr * a);
        float c = b2;
        for (int i = 0; i < FW; ++i) c += __shfl(h1, i) * w2[i * FW + lane];
        WSP(float, WS_H2)[row * FW + lane] = sinf(fr * c);
    }
}
__device__ __forceinline__ void norm_rows(const Args& args, Frame& F, int which, bf16* A) {
    const int gw = F.bid * NWAVES + F.wave, NGW = F.G * NWAVES;
    const float* g = args.in[which == 0 ? I_NF1 : which == 1 ? I_NMIX : I_NF2];
    const int sh_off = which * 3 * DM, sc_off = sh_off + DM;
    for (int m0 = gw; m0 < MTOK; m0 += 2 * NGW) {
        f32x4 v[2][4];
#pragma unroll
        for (int q = 0; q < 2; ++q) { const int m = m0 + q * NGW < MTOK ? m0 + q * NGW : m0;
            const float* xrow = which == 0 ? (m < NCTX ? args.in[I_XP] + (size_t)m * DM : args.in[I_XS] + (size_t)(m - NCTX) * DM) : F.out + (size_t)m * DM;
#pragma unroll
            for (int j = 0; j < 4; ++j) v[q][j] = *((const f32x4*)xrow + F.lane + 64 * j); }
#pragma unroll
        for (int q = 0; q < 2; ++q) { const int m = m0 + q * NGW; if (m >= MTOK) break;
            const float* mod = WSP(float, WS_MOD) + mod_row(m) * MODW;
            float s = 0.f;
#pragma unroll
            for (int j = 0; j < 4; ++j) s += (v[q][j].x * v[q][j].x + v[q][j].y * v[q][j].y) + (v[q][j].z * v[q][j].z + v[q][j].w * v[q][j].w);
            const float rstd = 1.0f / sqrtf(wave_sum(s) * (1.0f / DM) + EPSF);
#pragma unroll
            for (int j = 0; j < 4; ++j) { const int c = 4 * F.lane + 256 * j;
                const f32x4 gg = *(const f32x4*)(g + c), sc = *(const f32x4*)(mod + sc_off + c), sh = *(const f32x4*)(mod + sh_off + c);
                const f32x4 y = v[q][j] * rstd * gg * (sc + 1.0f) + sh;
                u32x2 o; o.x = pk2(y.x, y.y); o.y = pk2(y.z, y.w);
                *(u32x2*)(A + (size_t)m * DM + c) = o; } }
    }
}
__device__ __forceinline__ void norm_rows_b(const Args& args, Frame& F, int which, const bf16* X, bf16* A) {
    const int gw = F.bid * NWAVES + F.wave, NGW = F.G * NWAVES;
    const float* g = args.in[which == 1 ? I_NMIX : I_NF2];
    const int sh_off = which * 3 * DM, sc_off = sh_off + DM;
    for (int m0 = gw; m0 < MTOK; m0 += 2 * NGW) {
        u32x4 p[2][2];
#pragma unroll
        for (int q = 0; q < 2; ++q)
#pragma unroll
            for (int j = 0; j < 2; ++j) p[q][j] = *(const u32x4*)(X + (size_t)(m0 + q * NGW < MTOK ? m0 + q * NGW : m0) * DM + 8 * F.lane + 512 * j);
#pragma unroll
        for (int q = 0; q < 2; ++q) { const int m = m0 + q * NGW; if (m >= MTOK) break;
            const float* mod = WSP(float, WS_MOD) + mod_row(m) * MODW;
            float v[2][8]; float s = 0.f;
#pragma unroll
            for (int j = 0; j < 2; ++j) { const u32x4 pp = p[q][j];
                v[j][0] = bf2f(pp.x & 0xffffu); v[j][1] = bf2f(pp.x >> 16); v[j][2] = bf2f(pp.y & 0xffffu); v[j][3] = bf2f(pp.y >> 16); v[j][4] = bf2f(pp.z & 0xffffu); v[j][5] = bf2f(pp.z >> 16); v[j][6] = bf2f(pp.w & 0xffffu); v[j][7] = bf2f(pp.w >> 16);
#pragma unroll
                for (int i = 0; i < 8; ++i) s += v[j][i] * v[j][i]; }
            const float rstd = 1.0f / sqrtf(wave_sum(s) * (1.0f / DM) + EPSF);
#pragma unroll
            for (int j = 0; j < 2; ++j) { const int c = 8 * F.lane + 512 * j; float y[8];
#pragma unroll
                for (int h = 0; h < 2; ++h) { const f32x4 gg = *(const f32x4*)(g + c + 4 * h), sc = *(const f32x4*)(mod + sc_off + c + 4 * h), sh = *(const f32x4*)(mod + sh_off + c + 4 * h);
#pragma unroll
                    for (int i = 0; i < 4; ++i) y[4 * h + i] = v[j][4 * h + i] * rstd * gg[i] * (sc[i] + 1.0f) + sh[i]; }
                u32x4 o; o.x = pk2(y[0], y[1]); o.y = pk2(y[2], y[3]); o.z = pk2(y[4], y[5]); o.w = pk2(y[6], y[7]);
                *(u32x4*)(A + (size_t)m * DM + c) = o; } }
    }
}
__device__ __forceinline__ void split_hl(const f32x4 a, const f32x4 b, bf16x8& hi, bf16x8& lo) {
    const float v[8] = {a.x, a.y, a.z, a.w, b.x, b.y, b.z, b.w}; unsigned h[8], l[8];
#pragma unroll
    for (int j = 0; j < 8; ++j) { h[j] = f2bf(v[j]); l[j] = f2bf(v[j] - bf2f(h[j])); }
    const u32x4 hv = {h[0] | (h[1] << 16), h[2] | (h[3] << 16), h[4] | (h[5] << 16), h[6] | (h[7] << 16)}, lv = {l[0] | (l[1] << 16), l[2] | (l[3] << 16), l[4] | (l[5] << 16), l[6] | (l[7] << 16)};
    hi = __builtin_bit_cast(bf16x8, hv); lo = __builtin_bit_cast(bf16x8, lv);
}
__device__ __forceinline__ void p1_taps(const Args& args, Frame& F) {
    LAS float* red = (LAS float*)F.lds;
    LAS bf16* stg = (LAS bf16*)(F.lds + 1024) + F.wave * (32 * 40);
    const float* w3 = args.in[I_FW3]; const float* b3 = args.in[I_FB3]; const float* dec = args.in[I_FDEC];
    const int lane = F.lane, r = lane & 31, hh = lane >> 5;
    for (int u = F.bid; u < 384; u += F.G) {
        const int ntype = u >= 256, uu = ntype ? u - 256 : u >> 1, half = ntype ? 0 : u & 1, o = (uu >> 6) & 1, c0 = (uu & 63) * 16;
        const int n = ntype ? CSEQ : LSEQ, off = n - 1;
        const int dir = r >> 4, c = c0 + (r & 15), col = o * 2048 + dir * 1024 + c;
        bf16x8 bh[4], bl[4];
#pragma unroll
        for (int kk = 0; kk < 4; ++kk) { const float* wp = w3 + (size_t)(16 * kk + 8 * hh) * 4096 + col;
            const f32x4 x0 = {wp[0], wp[4096], wp[2 * 4096], wp[3 * 4096]}, x1 = {wp[4 * 4096], wp[5 * 4096], wp[6 * 4096], wp[7 * 4096]};
            split_hl(x0, x1, bh[kk], bl[kk]); }
        const float bb = b3[col], dd = fabsf(dec[col]), rn = 1.0f / (float)(n - 1);
        const float* h2 = WSP(float, WS_H2) + (ntype ? LSEQ * FW : 0);
        bf16* G = ntype ? WSP(bf16, WS_TAPC) + (size_t)(o * 1024 + c0) * 512 : WSP(bf16, WS_TAPL) + (size_t)(o * 1024 + c0) * 8192;
        const int gstride = ntype ? 512 : 8192;
        float asum = 0.f;
        const int tile_lo = ntype ? 0 : half * 64, tile_hi = ntype ? 8 : tile_lo + 64;
        for (int tile = tile_lo + F.wave; tile < tile_hi; tile += NWAVES) {
            const int t0 = tile * 32;
            const f32x4* hr = (const f32x4*)(h2 + (size_t)(t0 + r) * FW + 8 * hh);
            f32x16 acc = {};
#pragma unroll
            for (int kk = 0; kk < 4; ++kk) { bf16x8 ah, al; split_hl(hr[4 * kk], hr[4 * kk + 1], ah, al);
                acc = __builtin_amdgcn_mfma_f32_32x32x16_bf16(ah, bh[kk], acc, 0, 0, 0);
                acc = __builtin_amdgcn_mfma_f32_32x32x16_bf16(al, bh[kk], acc, 0, 0, 0);
                acc = __builtin_amdgcn_mfma_f32_32x32x16_bf16(ah, bl[kk], acc, 0, 0, 0); }
#pragma unroll
            for (int q = 0; q < 16; ++q) { const int tr = (q & 3) + 8 * (q >> 2) + 4 * hh; const float a = (acc[q] + bb) * __expf(-(float)(t0 + tr) * rn * dd);
                asum += fabsf(a); stg[r * 40 + tr] = (bf16)f2bf(a); }
            LDS_WAIT(); asm volatile("" ::: "memory");
#pragma unroll 4
            for (int i = 0; i < 16; ++i) { const int cc = 2 * i + hh, cdir = cc >> 4, t = t0 + r; const bf16 v = stg[cc * 40 + r];
                bf16* Gc = G + (size_t)(cc & 15) * gstride;
                if (cdir == 0) Gc[off - t] = v; else if (t > 0) Gc[off + t] = v; }
            LDS_WAIT(); asm volatile("" ::: "memory");
        }
        if (F.wave == 0 && lane < 16 && (ntype || half)) G[(size_t)lane * gstride + 2 * off + 1] = 0;
        asum += __shfl_xor(asum, 32); asum += __shfl_xor(asum, 16);
        if (lane < 16) red[F.wave * 16 + lane] = asum;
        __syncthreads();
        if (F.tid < 16) { float sacc = 0.f;
#pragma unroll
            for (int w = 0; w < 8; ++w) sacc += red[w * 16 + F.tid];
            float* ps = WSP(float, WS_INVS) + ((ntype * 2 + o) * 1024 + c0 + F.tid) * 2;
            ps[half] = sacc; if (ntype) ps[1] = 0.f; }
        __syncthreads();
    }
}

template <int NB, class RM0, class RM1, class EPI>
__device__ __forceinline__ void sgemm(const Args& args, Frame& F, const bf16* A, const bf16* Bt, int M, int N, int K, RM0 rm0, RM1 rm1, EPI epi) {
    const int gw = F.bid * NWAVES + F.wave, NGW = F.G * NWAVES, r = F.lane & 31, hh = F.lane >> 5;
    const int tn_cnt = N / 32, ntile = (M / 32) * tn_cnt;
    for (int it = gw; it < ntile; it += NGW) {
        const int tm = it / tn_cnt, tn = it % tn_cnt;
        const bf16* ap = A + (size_t)(tm * 32 + r) * K + 8 * hh;
        const bf16* bp0 = Bt + (size_t)rm0(tn * 32 + r) * K + 8 * hh;
        const bf16* bp1 = Bt + (size_t)rm1(tn * 32 + r) * K + 8 * hh;
        f32x16 acc0 = {}, acc1 = {};
#pragma unroll 4
        for (int k0 = 0; k0 < K; k0 += 16) {
            const bf16x8 a = *(const bf16x8*)(ap + k0), b0 = *(const bf16x8*)(bp0 + k0);
            acc0 = __builtin_amdgcn_mfma_f32_32x32x16_bf16(a, b0, acc0, 0, 0, 0);
            if (NB == 2) { const bf16x8 b1 = *(const bf16x8*)(bp1 + k0); acc1 = __builtin_amdgcn_mfma_f32_32x32x16_bf16(a, b1, acc1, 0, 0, 0); }
        }
#pragma unroll
        for (int q = 0; q < 16; ++q) epi(tm * 32 + (q & 3) + 8 * (q >> 2) + 4 * hh, tn * 32 + r, acc0[q], acc1[q]);
    }
}
struct RmId { __device__ __forceinline__ int operator()(int n) const { return n; } };
struct RmGate { __device__ __forceinline__ int operator()(int j) const { return map_swiglu(j); } };
struct RmUp { __device__ __forceinline__ int operator()(int j) const { return map_swiglu(DFF + j); } };

struct EpiSwiglu { bf16* U; __device__ __forceinline__ void operator()(int row, int col, float g, float u) const { U[(size_t)row * DFF + col] = (bf16)f2bf(g / (1.0f + __expf(-g)) * u); } };
struct EpiRes0 { const float* xp; const float* xs; float* out; const float* mod; int goff; float coef;
    __device__ __forceinline__ void operator()(int row, int col, float v, float) const {
        const float xin = row < NCTX ? xp[(size_t)row * DM + col] : xs[(size_t)(row - NCTX) * DM + col];
        out[(size_t)row * DM + col] = xin + coef * mod[mod_row(row) * MODW + goff + col] * v; } };
struct EpiRes1 { float* out; const float* mod; int goff; float coef;
    __device__ __forceinline__ void operator()(int row, int col, float v, float) const {
        out[(size_t)row * DM + col] += coef * mod[mod_row(row) * MODW + goff + col] * v; } };

struct RmHeadLo { __device__ __forceinline__ int operator()(int n) const { const int hd = n >> 5, d = n & 31; return map_qkv(hd * 64 + d); } };
struct RmHeadHi { __device__ __forceinline__ int operator()(int n) const { const int hd = n >> 5, d = n & 31; return map_qkv(hd * 64 + 32 + d); } };
constexpr float C2 = 0.125f * 1.4426950408889634f;

__device__ __forceinline__ void qkv_naive(const Args& args, Frame& F) {
    const bf16* A = WSP(bf16, WS_A); const bf16* Bt = WSP(bf16, WS_WQKV);
    const int gw = F.bid * NWAVES + F.wave, NGW = F.G * NWAVES, r = F.lane & 31, hh = F.lane >> 5;
    const int ntile = (MTOK / 32) * 24;
    const float qn_lo = args.in[I_QN][r], qn_hi = args.in[I_QN][32 + r], kn_lo = args.in[I_KN][r], kn_hi = args.in[I_KN][32 + r];
    const float invf = __powf(10000.0f, -(float)(r & 15) / 16.0f);
    for (int it = gw; it < ntile; it += NGW) {
        const int tm = it / 24, hd = it % 24;
        const bf16* ap = A + (size_t)(tm * 32 + r) * DM + 8 * hh;
        const bf16* bp0 = Bt + (size_t)map_qkv(hd * 64 + r) * DM + 8 * hh;
        const bf16* bp1 = Bt + (size_t)map_qkv(hd * 64 + 32 + r) * DM + 8 * hh;
        f32x16 a0 = {}, a1 = {};
#pragma unroll 4
        for (int k0 = 0; k0 < DM; k0 += 16) { const bf16x8 a = *(const bf16x8*)(ap + k0);
            a0 = __builtin_amdgcn_mfma_f32_32x32x16_bf16(a, *(const bf16x8*)(bp0 + k0), a0, 0, 0, 0);
            a1 = __builtin_amdgcn_mfma_f32_32x32x16_bf16(a, *(const bf16x8*)(bp1 + k0), a1, 0, 0, 0); }
#pragma unroll
        for (int q = 0; q < 16; ++q) {
            const int row = tm * 32 + (q & 3) + 8 * (q >> 2) + 4 * hh;
            float lo = a0[q], hi = a1[q];
            const bool lat = row >= NCTX; const int t = (row - NCTX) & (LSEQ - 1), bl = (row - NCTX) >> 12;
            if (hd < 20) {
                float ss = lo * lo + hi * hi;
#pragma unroll
                for (int o = 1; o < 32; o <<= 1) ss += __shfl_xor(ss, o);
                const float rs = 1.0f / sqrtf(ss * (1.0f / 64.0f) + EPSF);
                lo *= rs * (hd < 16 ? qn_lo : kn_lo); hi *= rs * (hd < 16 ? qn_hi : kn_hi);
                if (!lat && hd >= 16) { F.out[OUT_NK + (size_t)row * KVW + (hd - 16) * 64 + r] = lo; F.out[OUT_NK + (size_t)row * KVW + (hd - 16) * 64 + 32 + r] = hi; }
                const float plo = __shfl_xor(lo, 16), phi = __shfl_xor(hi, 16);
                if (lat) {
                    const float angr = (float)(t >> 6) * invf, angc = (float)(t & 63) * invf;
                    const float cr = cosf(angr), sr = sinf(angr), cc = cosf(angc), sc = sinf(angc);
                    lo = (r & 16) ? lo * cr + plo * sr : lo * cr - plo * sr;
                    hi = (r & 16) ? hi * cc + phi * sc : hi * cc - phi * sc;
                }
            } else if (!lat) { F.out[OUT_NV + (size_t)row * KVW + (hd - 20) * 64 + r] = lo; F.out[OUT_NV + (size_t)row * KVW + (hd - 20) * 64 + 32 + r] = hi; }
            if (hd < 16) { bf16* Q = WSP(bf16, WS_Q) + (size_t)row * DM + hd * 64; Q[r] = (bf16)f2bf(lo * C2); Q[32 + r] = (bf16)f2bf(hi * C2); }
            else {
                const int kvh = (hd - 16) & 3; const bool isk = hd < 20;
                bf16* dst = lat ? WSP(bf16, isk ? WS_KL : WS_VL) + ((size_t)bl * KLROWS + PAST + t) * KVW : WSP(bf16, isk ? WS_KC : WS_VC) + (size_t)row * KVW;
                dst[kvh * 64 + r] = (bf16)f2bf(lo); dst[kvh * 64 + 32 + r] = (bf16)f2bf(hi);
            }
        }
    }
}
__device__ __forceinline__ void cache_rows(const Args& args, Frame& F) {
    const size_t gt = (size_t)F.bid * NTHR + F.tid, NGT = (size_t)F.G * NTHR;
    for (size_t i = gt; i < (size_t)8 * PAST * KVW / 4; i += NGT) {
        const size_t e = i * 4, bl = e / (PAST * KVW), rem = e % (PAST * KVW);
        const f32x4 k = *(const f32x4*)(args.in[I_CK] + e), v = *(const f32x4*)(args.in[I_CV] + e);
        u32x2 ko, vo; ko.x = pk2(k.x, k.y); ko.y = pk2(k.z, k.w); vo.x = pk2(v.x, v.y); vo.y = pk2(v.z, v.w);
        *(u32x2*)(WSP(bf16, WS_KL) + bl * KLROWS * KVW + rem) = ko; *(u32x2*)(WSP(bf16, WS_VL) + bl * KLROWS * KVW + rem) = vo;
    }
    for (size_t i = gt; i < (size_t)8 * KLPAD * KVW / 4; i += NGT) {
        const size_t e = i * 4, bl = e / (KLPAD * KVW), rem = e % (KLPAD * KVW);
        u32x2 z; z.x = 0; z.y = 0;
        *(u32x2*)(WSP(bf16, WS_KL) + (bl * KLROWS + PAST + LSEQ) * KVW + rem) = z; *(u32x2*)(WSP(bf16, WS_VL) + (bl * KLROWS + PAST + LSEQ) * KVW + rem) = z;
    }
}
struct EpiHyT { bf16* H; __device__ __forceinline__ void operator()(int row, int col, float v, float) const { H[(size_t)row * MTOK + col] = (bf16)f2bf(v); } };

__device__ __forceinline__ void attn_naive(const Args& args, Frame& F) {
    const size_t gt = (size_t)F.bid * NTHR + F.tid, NGT = (size_t)F.G * NTHR;
    for (size_t idx = gt; idx < (size_t)MTOK * NH; idx += NGT) {
        const int h = (int)(idx / MTOK), m = (int)(idx % MTOK), kvh = h >> 2;
        const bool lat = m >= NCTX; const int t = (m - NCTX) & (LSEQ - 1), bl = (m - NCTX) >> 12;
        bf16* qp = WSP(bf16, WS_Q) + (size_t)m * DM + h * 64;
        float q[64], o[64];
#pragma unroll
        for (int d = 0; d < 64; ++d) { q[d] = bf2f(qp[d]); o[d] = 0.f; }
        const bf16* kb; const bf16* vb; int k_lo, k_hi;
        if (lat) { kb = WSP(bf16, WS_KL) + (size_t)bl * KLROWS * KVW + kvh * 64; vb = WSP(bf16, WS_VL) + (size_t)bl * KLROWS * KVW + kvh * 64;
            const int a = t - WIN < 0 ? 0 : t - WIN, b = t + WIN > LSEQ - 1 ? LSEQ - 1 : t + WIN; k_lo = PAST + a; k_hi = PAST + b + 1; }
        else { const int bc = m >> 8; kb = WSP(bf16, WS_KC) + (size_t)bc * CSEQ * KVW + kvh * 64; vb = WSP(bf16, WS_VC) + (size_t)bc * CSEQ * KVW + kvh * 64; k_lo = 0; k_hi = CSEQ; }
        float mx = args.in[I_SINK][h] * 1.4426950408889634f, l = 1.0f;
        const int n1 = lat ? PAST : 0;
        for (int pass = 0; pass < 2; ++pass) {
            const int lo = pass == 0 ? 0 : k_lo, hi = pass == 0 ? n1 : k_hi;
            for (int kr = lo; kr < hi; ++kr) {
                const bf16* kp = kb + (size_t)kr * KVW; const bf16* vp = vb + (size_t)kr * KVW;
                float s = 0.f;
#pragma unroll
                for (int d8 = 0; d8 < 8; ++d8) { const u32x4 kk = *(const u32x4*)(kp + 8 * d8);
                    s += q[8 * d8] * bf2f(kk.x & 0xffff) + q[8 * d8 + 1] * bf2f(kk.x >> 16) + q[8 * d8 + 2] * bf2f(kk.y & 0xffff) + q[8 * d8 + 3] * bf2f(kk.y >> 16)
                       + q[8 * d8 + 4] * bf2f(kk.z & 0xffff) + q[8 * d8 + 5] * bf2f(kk.z >> 16) + q[8 * d8 + 6] * bf2f(kk.w & 0xffff) + q[8 * d8 + 7] * bf2f(kk.w >> 16); }
                const float mn = fmaxf(mx, s), f = exp2f(mx - mn), p = exp2f(s - mn);
                l = l * f + p; mx = mn;
#pragma unroll
                for (int d8 = 0; d8 < 8; ++d8) { const u32x4 vv = *(const u32x4*)(vp + 8 * d8);
                    o[8 * d8] = o[8 * d8] * f + p * bf2f(vv.x & 0xffff); o[8 * d8 + 1] = o[8 * d8 + 1] * f + p * bf2f(vv.x >> 16);
                    o[8 * d8 + 2] = o[8 * d8 + 2] * f + p * bf2f(vv.y & 0xffff); o[8 * d8 + 3] = o[8 * d8 + 3] * f + p * bf2f(vv.y >> 16);
                    o[8 * d8 + 4] = o[8 * d8 + 4] * f + p * bf2f(vv.z & 0xffff); o[8 * d8 + 5] = o[8 * d8 + 5] * f + p * bf2f(vv.z >> 16);
                    o[8 * d8 + 6] = o[8 * d8 + 6] * f + p * bf2f(vv.w & 0xffff); o[8 * d8 + 7] = o[8 * d8 + 7] * f + p * bf2f(vv.w >> 16); }
            }
        }
        const float il = 1.0f / l;
#pragma unroll
        for (int d = 0; d < 64; d += 2) *(unsigned*)(qp + d) = pk2(o[d] * il, o[d + 1] * il);
    }
}
__device__ __forceinline__ float hy_u(const bf16* rowp, int t, int n, const float* cw, int ch, float cb) {
    const float a = t > 0 ? bf2f(rowp[t - 1]) : 0.f, b = bf2f(rowp[t]), c = t + 1 < n ? bf2f(rowp[t + 1]) : 0.f;
    return a * cw[ch] + b * cw[NHY + ch] + c * cw[2 * NHY + ch] + cb;
}
__device__ __forceinline__ void hyena_naive(const Args& args, Frame& F) {
    LAS float* kt = (LAS float*)F.lds;
    LAS float* z = kt + 8192;
    LAS float* y = z + 4096;
    const float* cw = args.in[I_CW]; const float* cbv = args.in[I_CB];
    const int NU = 1024 * 8 + 1024 * 16;
    for (int u = F.bid; u < NU; u += F.G) {
        const bool lat = u < 8192; const int c = lat ? u >> 3 : (u - 8192) >> 4, b = lat ? u & 7 : (u - 8192) & 15;
        const int n = lat ? LSEQ : CSEQ, off = n - 1;
        const size_t tok0 = lat ? (size_t)NCTX + (size_t)b * LSEQ : (size_t)b * CSEQ;
        const bf16* r1 = WSP(bf16, WS_HYT) + (size_t)c * MTOK + tok0; const bf16* r2 = r1 + (size_t)1024 * MTOK; const bf16* r3 = r1 + (size_t)2048 * MTOK;
        for (int t = F.tid; t < n; t += NTHR) z[t] = bf2f(f2bf(hy_u(r3, t, n, cw, 2048 + c, cbv[2048 + c])));
        for (int o = 0; o < 2; ++o) {
            const bf16* G = lat ? WSP(bf16, WS_TAPL) + (size_t)(o * 1024 + c) * 8192 : WSP(bf16, WS_TAPC) + (size_t)(o * 1024 + c) * 512;
            const float* ps = WSP(float, WS_INVS) + (((lat ? 0 : 1) * 2 + o) * 1024 + c) * 2;
            const float invs = 1.0f / (ps[0] + ps[1] + EPSF), skip = args.in[I_HSKIP][o * 1024 + c];
            __syncthreads();
            for (int i = F.tid; i < 2 * n - 1; i += NTHR) { float kv = bf2f(G[i]) * invs; if (i == off) kv += skip; kt[2 * off - i] = bf2f(f2bf(kv)); }
            __syncthreads();
            for (int t = F.tid; t < n; t += NTHR) { float a = 0.f; for (int s = 0; s < n; ++s) a += kt[t - s + off] * z[s]; y[t] = a; }
            __syncthreads();
            if (o == 0) { for (int t = F.tid; t < n; t += NTHR) z[t] = bf2f(f2bf(hy_u(r1, t, n, cw, c, cbv[c]) * y[t])); }
            else { for (int t = F.tid; t < n; t += NTHR) y[t] = hy_u(r2, t, n, cw, 1024 + c, cbv[1024 + c]) * y[t]; }
        }
        __syncthreads();
        bf16* dst = WSP(bf16, WS_HYT) + (size_t)c * MTOK + tok0;
        for (int t = F.tid; t < n; t += NTHR) dst[t] = (bf16)f2bf(y[t]);
        __syncthreads();
    }
}
template <bool LAT> struct HyGeo {
    static constexpr int NSEQ = LAT ? 4096 : 256, NBT = LAT ? 8 : 16, NCH = LAT ? 1 : 4, ZB = NSEQ + 6 * 64 + 8, CS = NSEQ + 16  , NCOPY = 4, OFF = NSEQ - 1, NT = LAT ? 2 : 1;
    static constexpr int ZBYTES = NBT * ZB * 2, TAPBYTES = (NCOPY * CS * 4 + 15) & ~15, CHBYTES = ZBYTES + TAPBYTES;
    static_assert(ZBYTES % 16 == 0 && CHBYTES % 16 == 0 && (ZB / 2) % 64 == 4 && CS % 64 == 16 && NCH * CHBYTES <= 147392 - 64, "hyena LDS geometry");
};
__device__ __forceinline__ float bflo_(unsigned w) { return __builtin_bit_cast(float, w << 16); }
__device__ __forceinline__ float bfhi_(unsigned w) { return __builtin_bit_cast(float, w & 0xffff0000u); }
__device__ __forceinline__ unsigned pkbf(float lo, float hi) { typedef float f2 __attribute__((ext_vector_type(2))); typedef __bf16 b2 __attribute__((ext_vector_type(2))); f2 v = {lo, hi}; b2 b = __builtin_convertvector(v, b2); return __builtin_bit_cast(unsigned, b); }
__device__ __forceinline__ f32x4 sconv4(u32x2 cur, float l, float r, float w0, float w1, float w2, float cb) {
    const float u0 = bflo_(cur.x), u1 = bfhi_(cur.x), u2 = bflo_(cur.y), u3 = bfhi_(cur.y);
    f32x4 y; y.x = w0 * l + w1 * u0 + w2 * u1 + cb; y.y = w0 * u0 + w1 * u1 + w2 * u2 + cb; y.z = w0 * u1 + w1 * u2 + w2 * u3 + cb; y.w = w0 * u2 + w1 * u3 + w2 * r + cb; return y;
}
template <int NT, bool T0, bool T1> __device__ __forceinline__ void toep_range(f32x16 (&acc)[NT][2], LAS const unsigned char* ab, LAS const unsigned char* zb, int ds, int de) {
    bf16x8 afA[6], afB[6], bfA[2][4], bfB[2][4];
#define HY_LA(AF, AP, DL) do { LAS const u32x2* p_ = (LAS const u32x2*)((AP) + ((DL) - 2) * 8); const u32x2 l_ = p_[0], h_ = p_[1]; const u32x4 t_ = {l_.x, l_.y, h_.x, h_.y}; AF[DL] = __builtin_bit_cast(bf16x8, t_); } while (0)
#define HY_LB(BF, ZP, KK) do { if (T0) BF[0][KK] = *(LAS const bf16x8*)((ZP) + (KK) * 32); if (T1) BF[1][KK] = *(LAS const bf16x8*)((ZP) + 512 + (KK) * 32); } while (0)
#define HY_LG(AF, BF, AP, ZP, G) do { if ((G) == 0) { HY_LA(AF, AP, 0); HY_LA(AF, AP, 2); } else if ((G) == 1) { HY_LA(AF, AP, 1); HY_LA(AF, AP, 3); } else if ((G) == 2) { HY_LA(AF, AP, 4); } else { HY_LA(AF, AP, 5); } \
        HY_LB(BF, ZP, G); } while (0)
#define HY_MG(AF, BF, KK) do { \
        if (T0) { acc[0][0] = __builtin_amdgcn_mfma_f32_32x32x16_bf16(AF[(KK) + 2], BF[0][KK], acc[0][0], 0, 0, 0); acc[0][1] = __builtin_amdgcn_mfma_f32_32x32x16_bf16(AF[KK], BF[0][KK], acc[0][1], 0, 0, 0); } \
        if (T1) { acc[NT - 1][0] = __builtin_amdgcn_mfma_f32_32x32x16_bf16(AF[(KK) + 2], BF[1][KK], acc[NT - 1][0], 0, 0, 0); acc[NT - 1][1] = __builtin_amdgcn_mfma_f32_32x32x16_bf16(AF[KK], BF[1][KK], acc[NT - 1][1], 0, 0, 0); } } while (0)
#define HY_STEP(AFC, BFC, AFN, BFN, DN) do { const int dn_ = (DN); LAS const unsigned* apn_ = (LAS const unsigned*)(ab - dn_ * 128); LAS const unsigned char* zpn_ = zb - dn_ * 128; \
        _Pragma("unroll") for (int g_ = 0; g_ < 4; ++g_) { HY_LG(AFN, BFN, apn_, zpn_, g_); __builtin_amdgcn_sched_barrier(0); HY_MG(AFC, BFC, g_); __builtin_amdgcn_sched_barrier(0); } } while (0)
    { LAS const unsigned* ap0 = (LAS const unsigned*)(ab - ds * 128); LAS const unsigned char* zp0 = zb - ds * 128;
#pragma unroll
      for (int g = 0; g < 4; ++g) HY_LG(afA, bfA, ap0, zp0, g); }
    int D = ds;
#pragma unroll 1
    for (; D + 1 <= de; D += 2) {
        HY_STEP(afA, bfA, afB, bfB, D + 1);
        HY_STEP(afB, bfB, afA, bfA, (D + 2 <= de ? D + 2 : de));
    }
    if (D == de) {
#pragma unroll
        for (int g = 0; g < 4; ++g) HY_MG(afA, bfA, g);
    }
#undef HY_LA
#undef HY_LB
#undef HY_LG
#undef HY_MG
#undef HY_STEP
}
template <int NT> __device__ __forceinline__ void toep_conv(f32x16 (&acc)[NT][2], LAS const unsigned char* ab, LAS const unsigned char* zb, int d_lo, int d_hi, int t0_hi, int t1_lo) {
    if (NT == 1) { toep_range<NT, true, false>(acc, ab, zb, d_lo, d_hi); return; }
    toep_range<NT, true, false>(acc, ab, zb, d_lo, t1_lo - 1);
    toep_range<NT, true, true>(acc, ab, zb, t1_lo, t0_hi);
    toep_range<NT, false, true>(acc, ab, zb, t0_hi + 1, d_hi);
}
template <bool LAT> __device__ __forceinline__ void hyena_fast(const Args& args, Frame& F, bool dry = false) {
    typedef HyGeo<LAT> H;
    constexpr int NSEQ = H::NSEQ, NBT = H::NBT, NCH = H::NCH, ZB = H::ZB, CS = H::CS, OFF = H::OFF, NT = H::NT;
    constexpr int NV = NCH * NBT * NSEQ / 8 / NTHR;
    constexpr int NTC = NCH * (NSEQ * 2 / 16);
    const float* cw = args.in[I_CW]; const float* cbv = args.in[I_CB];
    const int lane = F.lane, r = lane & 31, hh = lane >> 5, w = F.wave;
    const int mych = LAT ? 0 : (w >> 1);
    LAS unsigned char* zreg = F.lds + mych * H::CHBYTES; LAS unsigned char* treg = zreg + H::ZBYTES;
    const int s0 = OFF - r + 8 * hh;
    const int cpy = s0 & 3;
    LAS const unsigned char* ab = treg + cpy * (CS * 4) + 2 * (s0 - cpy);
    const int tl = r >> 3, bcol = (LAT ? 0 : 8 * (w & 1)) + (r & 7), T0 = LAT ? 8 * w : 0;
    LAS const unsigned char* zb = zreg + 2 * (bcol * ZB + (T0 + tl + 3) * 64 + 8 * hh);
    const int d_lo = LAT ? 8 * w - 63 : -3, d_hi = LAT ? 8 * w + 7 : 3, t0_hi = 8 * w + 3, t1_lo = 8 * w - 59;
    const size_t tokb = LAT ? (size_t)NCTX : 0;
    bf16* rows = WSP(bf16, WS_HYT) + tokb;
    const int NU = 1024 / NCH;
    if (F.bid >= NU) return;
    for (int q = F.tid; q < NCH * NBT * 49; q += NTHR) {
        const int ch = q / (NBT * 49), b = (q / 49) % NBT, i = q % 49; const u32x4 zz = {0u, 0u, 0u, 0u};
        *(LAS u32x4*)(F.lds + ch * H::CHBYTES + 2 * (b * ZB + (i < 24 ? i * 8 : 192 + NSEQ + (i - 24) * 8))) = zz;
    }
    u32x4 vcur[NV]; unsigned vnb[NV];
    u32x4 tg0, tg1; u32x2 tgx; float tinv = 0.f, tskip = 0.f;
#define HY_VISSUE(C0) do { _Pragma("unroll") for (int i = 0; i < NV; ++i) { const int q = tid_ + i * NTHR, ch = q / (NBT * NSEQ / 8), b = (q / (NSEQ / 8)) % NBT, t0 = (q % (NSEQ / 8)) * 8; \
        const bf16* rp = rows + (size_t)(2048 + (C0) + ch) * MTOK + (size_t)b * NSEQ + t0; vcur[i] = *(const u32x4*)rp; vnb[i] = (unsigned)rp[-1] | ((unsigned)rp[8] << 16); } } while (0)
#define HY_VWRITE(C0) do { _Pragma("unroll") for (int i = 0; i < NV; ++i) { const int q = tid_ + i * NTHR, ch = q / (NBT * NSEQ / 8), b = (q / (NSEQ / 8)) % NBT, t0 = (q % (NSEQ / 8)) * 8, c = (C0) + ch; \
        const float l = t0 > 0 ? bflo_(vnb[i]) : 0.f, rr = t0 + 8 < NSEQ ? bfhi_(vnb[i]) : 0.f; \
        const float w0 = cw[2048 + c], w1 = cw[NHY + 2048 + c], w2 = cw[2 * NHY + 2048 + c], cb = cbv[2048 + c]; \
        u32x2 lo2, hi2; lo2.x = vcur[i].x; lo2.y = vcur[i].y; hi2.x = vcur[i].z; hi2.y = vcur[i].w; \
        const f32x4 ya = sconv4(lo2, l, bflo_(vcur[i].z), w0, w1, w2, cb), yb = sconv4(hi2, bfhi_(vcur[i].y), rr, w0, w1, w2, cb); \
        u32x4 o_; o_.x = pkbf(ya.x, ya.y); o_.y = pkbf(ya.z, ya.w); o_.z = pkbf(yb.x, yb.y); o_.w = pkbf(yb.z, yb.w); \
        *(LAS u32x4*)(F.lds + ch * H::CHBYTES + 2 * (b * ZB + 192 + t0)) = o_; } } while (0)
#define HY_TISSUE(O, C0) do { if (tid_ < NTC) { const int ch = tid_ / (NSEQ * 2 / 16), i0 = (tid_ % (NSEQ * 2 / 16)) * 16, c = (C0) + ch; \
        const bf16* G = LAT ? WSP(bf16, WS_TAPL) + (size_t)((O) * 1024 + c) * 8192 : WSP(bf16, WS_TAPC) + (size_t)((O) * 1024 + c) * 512; \
        const float* ps = WSP(float, WS_INVS) + (((LAT ? 0 : 1) * 2 + (O)) * 1024 + c) * 2; \
        tinv = 1.0f / (ps[0] + ps[1] + EPSF); tskip = args.in[I_HSKIP][(O) * 1024 + c]; \
        tg0 = *(const u32x4*)(G + i0); tg1 = *(const u32x4*)(G + i0 + 8); tgx = i0 + 16 < NSEQ * 2 ? *(const u32x2*)(G + i0 + 16) : (u32x2){0u, 0u}; } } while (0)
#define HY_TWRITE() do { if (tid_ < NTC) { const int ch = tid_ / (NSEQ * 2 / 16), i0 = (tid_ % (NSEQ * 2 / 16)) * 16; \
        float v[20] = {bflo_(tg0.x), bfhi_(tg0.x), bflo_(tg0.y), bfhi_(tg0.y), bflo_(tg0.z), bfhi_(tg0.z), bflo_(tg0.w), bfhi_(tg0.w), \
                       bflo_(tg1.x), bfhi_(tg1.x), bflo_(tg1.y), bfhi_(tg1.y), bflo_(tg1.z), bfhi_(tg1.z), bflo_(tg1.w), bfhi_(tg1.w), bflo_(tgx.x), bfhi_(tgx.x), bflo_(tgx.y), 0.f}; \
        _Pragma("unroll") for (int j = 0; j < 19; ++j) { v[j] *= tinv; if (i0 + j == OFF) v[j] += tskip; } \
        LAS unsigned char* tb = F.lds + ch * H::CHBYTES + H::ZBYTES; \
        _Pragma("unroll") for (int cc = 0; cc < 4; ++cc) { \
            u32x4 a0, a1; a0.x = pkbf(v[cc], v[cc + 1]); a0.y = pkbf(v[cc + 2], v[cc + 3]); a0.z = pkbf(v[cc + 4], v[cc + 5]); a0.w = pkbf(v[cc + 6], v[cc + 7]); \
            a1.x = pkbf(v[cc + 8], v[cc + 9]); a1.y = pkbf(v[cc + 10], v[cc + 11]); a1.z = pkbf(v[cc + 12], v[cc + 13]); a1.w = pkbf(v[cc + 14], v[cc + 15]); \
            *(LAS u32x4*)(tb + cc * (CS * 4) + 2 * i0) = a0; *(LAS u32x4*)(tb + cc * (CS * 4) + 2 * i0 + 16) = a1; } } } while (0)
    u32x4 xq[NT][8]; unsigned xe[NT];
#define HY_XISSUE(RT, C) do { const bf16* rpl = rows + (size_t)((RT) * 1024 + (C)) * MTOK + (size_t)bcol * NSEQ + 64 * (T0 + tl); \
        _Pragma("unroll") for (int t = 0; t < NT; ++t) { const bf16* rp = rpl + 256 * t; \
            _Pragma("unroll") for (int k = 0; k < 8; ++k) xq[t][k] = *(const u32x4*)(rp + 8 * k); \
            xe[t] = (unsigned)rp[-1] | ((unsigned)rp[64] << 16); } } while (0)
#define HY_EPI(RT, C) do { const float w0 = cw[(RT) * 1024 + (C)], w1 = cw[NHY + (RT) * 1024 + (C)], w2 = cw[2 * NHY + (RT) * 1024 + (C)], cb = cbv[(RT) * 1024 + (C)]; \
        _Pragma("unroll") for (int t = 0; t < NT; ++t) _Pragma("unroll") for (int ih = 0; ih < 2; ++ih) _Pragma("unroll") for (int g = 0; g < 4; ++g) { \
            const int k = 4 * ih + g, tt = 64 * (T0 + 4 * t + tl) + 8 * k + 4 * hh; \
            const u32x4 q_ = xq[t][k]; u32x2 cur; cur.x = hh ? q_.z : q_.x; cur.y = hh ? q_.w : q_.y; \
            const unsigned lw = k > 0 ? xq[t][k > 0 ? k - 1 : 0].w : (xe[t] << 16), rw = k < 7 ? xq[t][k < 7 ? k + 1 : 7].x : (xe[t] >> 16); \
            float l = hh ? bfhi_(q_.y) : bfhi_(lw), rr = hh ? bflo_(rw) : bflo_(q_.z); \
            if (tt == 0) l = 0.f; if (tt + 4 == NSEQ) rr = 0.f; \
            const f32x4 x = sconv4(cur, l, rr, w0, w1, w2, cb); \
            u32x2 ov; ov.x = pkbf(x.x * acc[t][ih][4 * g], x.y * acc[t][ih][4 * g + 1]); ov.y = pkbf(x.z * acc[t][ih][4 * g + 2], x.w * acc[t][ih][4 * g + 3]); \
            *(LAS u32x2*)(zreg + 2 * (bcol * ZB + 192 + tt)) = ov; } } while (0)
#define HY_CONV(RT, C, EARLY) do { _Pragma("unroll") for (int t = 0; t < NT; ++t) { acc[t][0] = f32x16{}; acc[t][1] = f32x16{}; } \
        if (NT == 1) { HY_XISSUE(RT, C); if (!(DRY_NOCONV && dry)) toep_range<NT, true, false>(acc, ab, zb, d_lo, d_hi); } \
        else { if (!(DRY_NOCONV && dry)) { toep_range<NT, true, false>(acc, ab, zb, d_lo, t1_lo - 1); toep_range<NT, true, true>(acc, ab, zb, t1_lo, t0_hi); } \
               if (EARLY) HY_XISSUE(RT, C); if (!(DRY_NOCONV && dry)) toep_range<NT, false, true>(acc, ab, zb, t0_hi + 1, d_hi); if (!(EARLY)) HY_XISSUE(RT, C); } } while (0)
    f32x16 acc[NT][2];
    int tid_ = F.tid; asm volatile("" : "+v"(tid_));
    { const int c0 = F.bid * NCH; HY_VISSUE(c0); HY_TISSUE(0, c0); HY_VWRITE(c0); HY_TWRITE(); }
    __syncthreads();
#pragma unroll 1
    for (int u = F.bid; u < NU; u += F.G) {
        const int c0 = u * NCH, c = c0 + mych, un = u + F.G; const bool has_next = un < NU;
        asm volatile("" : "+v"(tid_));
        HY_CONV(0, c, false);
        __builtin_amdgcn_sched_barrier(0);
        HY_TISSUE(1, c0);
        __syncthreads();
        HY_EPI(0, c); HY_TWRITE();
        __syncthreads();
        HY_CONV(1, c, false);
        __syncthreads();
        HY_EPI(1, c);
        __builtin_amdgcn_sched_barrier(0);
        { const int cn = (has_next ? un : u) * NCH; HY_VISSUE(cn); HY_TISSUE(0, cn); }
        __syncthreads();
        for (int q = tid_; q < NCH * NBT * NSEQ / 8; q += NTHR) {
            const int ch = q / (NBT * NSEQ / 8), b = (q / (NSEQ / 8)) % NBT, t0 = (q % (NSEQ / 8)) * 8;
            const u32x4 o = *(LAS const u32x4*)(F.lds + ch * H::CHBYTES + 2 * (b * ZB + 192 + t0));
            if (!dry) *(u32x4*)(rows + (size_t)(c0 + ch) * MTOK + (size_t)b * NSEQ + t0) = o;
        }
        __syncthreads();
        if (has_next) { HY_VWRITE(un * NCH); HY_TWRITE(); }
        __syncthreads();
    }
#undef HY_VISSUE
#undef HY_VWRITE
#undef HY_TISSUE
#undef HY_TWRITE
#undef HY_XISSUE
#undef HY_EPI
#undef HY_CONV
}
typedef float f32x2 __attribute__((ext_vector_type(2)));
namespace hfft {
constexpr int N = 8192, BUFC = N + 2 * (N >> 5)  , BUFB = BUFC * 8;
struct cpx { float x, y; };
template <int E, bool INV> __device__ __forceinline__ void bfly(cpx& p, cpx& q) {
    constexpr float C1 = 0.92387953251f, S1 = 0.38268343236f, H = 0.70710678118f;
    const float ax = p.x, ay = p.y, bx = q.x, by = q.y; float px, py, qx, qy, t0, t1;
    if constexpr (E == 0) asm("v_add_f32 %0, %4, %6\n\tv_add_f32 %1, %5, %7\n\tv_sub_f32 %2, %4, %6\n\tv_sub_f32 %3, %5, %7" : "=&v"(px), "=&v"(py), "=&v"(qx), "=&v"(qy) : "v"(ax), "v"(ay), "v"(bx), "v"(by));
    else if constexpr (E == 4) { if (INV) asm("v_add_f32 %0, %4, %6\n\tv_add_f32 %1, %5, %7\n\tv_sub_f32 %2, %7, %5\n\tv_sub_f32 %3, %4, %6" : "=&v"(px), "=&v"(py), "=&v"(qx), "=&v"(qy) : "v"(ax), "v"(ay), "v"(bx), "v"(by));
        else asm("v_add_f32 %0, %4, %6\n\tv_add_f32 %1, %5, %7\n\tv_sub_f32 %2, %5, %7\n\tv_sub_f32 %3, %6, %4" : "=&v"(px), "=&v"(py), "=&v"(qx), "=&v"(qy) : "v"(ax), "v"(ay), "v"(bx), "v"(by)); }
    else if constexpr (E == 2 || E == 6) {
        constexpr float hx = (E == 6 && INV) ? -H : H, hy = (E == 6 && !INV) ? -H : H;
        if ((E == 2 && !INV) || (E == 6 && INV))
            asm("v_add_f32 %0, %6, %8\n\tv_add_f32 %1, %7, %9\n\tv_sub_f32 %4, %6, %8\n\tv_sub_f32 %5, %7, %9\n\tv_add_f32 %2, %4, %5\n\tv_sub_f32 %3, %5, %4\n\tv_mul_f32 %2, %10, %2\n\tv_mul_f32 %3, %11, %3"
                : "=&v"(px), "=&v"(py), "=&v"(qx), "=&v"(qy), "=&v"(t0), "=&v"(t1) : "v"(ax), "v"(ay), "v"(bx), "v"(by), "s"(hx), "s"((E == 6 && INV) ? -hy : hy));
        else
            asm("v_add_f32 %0, %6, %8\n\tv_add_f32 %1, %7, %9\n\tv_sub_f32 %4, %6, %8\n\tv_sub_f32 %5, %7, %9\n\tv_sub_f32 %2, %4, %5\n\tv_add_f32 %3, %4, %5\n\tv_mul_f32 %2, %10, %2\n\tv_mul_f32 %3, %11, %3"
                : "=&v"(px), "=&v"(py), "=&v"(qx), "=&v"(qy), "=&v"(t0), "=&v"(t1) : "v"(ax), "v"(ay), "v"(bx), "v"(by), "s"((E == 6 && !INV) ? -hx : hx), "s"(hy));
    } else { constexpr float c = E == 1 ? C1 : E == 3 ? S1 : E == 5 ? -S1 : -C1, s = (E == 1 || E == 7) ? S1 : C1;
        if (INV) asm("v_add_f32 %0, %6, %8\n\tv_add_f32 %1, %7, %9\n\tv_sub_f32 %4, %6, %8\n\tv_sub_f32 %5, %7, %9\n\tv_mul_f32 %2, %11, %5\n\tv_mul_f32 %3, %11, %4\n\tv_fma_f32 %2, %10, %4, -%2\n\tv_fma_f32 %3, %10, %5, %3"
                : "=&v"(px), "=&v"(py), "=&v"(qx), "=&v"(qy), "=&v"(t0), "=&v"(t1) : "v"(ax), "v"(ay), "v"(bx), "v"(by), "s"(c), "s"(s));
        else asm("v_add_f32 %0, %6, %8\n\tv_add_f32 %1, %7, %9\n\tv_sub_f32 %4, %6, %8\n\tv_sub_f32 %5, %7, %9\n\tv_mul_f32 %2, %11, %5\n\tv_mul_f32 %3, %11, %4\n\tv_fma_f32 %2, %10, %4, %2\n\tv_fma_f32 %3, %10, %5, -%3"
                : "=&v"(px), "=&v"(py), "=&v"(qx), "=&v"(qy), "=&v"(t0), "=&v"(t1) : "v"(ax), "v"(ay), "v"(bx), "v"(by), "s"(c), "s"(s)); }
    p = cpx{px, py}; q = cpx{qx, qy};
}
template <bool CONJ> __device__ __forceinline__ cpx cmulw(cpx a, f32x2 w) { float rx, ry;
    if (CONJ) asm("v_mul_f32 %0, %3, %5\n\tv_mul_f32 %1, %2, %5\n\tv_fma_f32 %0, %2, %4, %0\n\tv_fma_f32 %1, %3, %4, -%1" : "=&v"(rx), "=&v"(ry) : "v"(a.x), "v"(a.y), "v"(w.x), "v"(w.y));
    else asm("v_mul_f32 %0, %3, %5\n\tv_mul_f32 %1, %3, %4\n\tv_fma_f32 %0, %2, %4, -%0\n\tv_fma_f32 %1, %2, %5, %1" : "=&v"(rx), "=&v"(ry) : "v"(a.x), "v"(a.y), "v"(w.x), "v"(w.y));
    return cpx{rx, ry}; }
template <bool CONJ> __device__ __forceinline__ cpx cmulk(cpx a, float c, float s) { float rx, ry;
    if (CONJ) asm("v_mul_f32 %0, %5, %3\n\tv_mul_f32 %1, %5, %2\n\tv_fma_f32 %0, %4, %2, %0\n\tv_fma_f32 %1, %4, %3, -%1" : "=&v"(rx), "=&v"(ry) : "v"(a.x), "v"(a.y), "s"(c), "s"(s));
    else asm("v_mul_f32 %0, %5, %3\n\tv_mul_f32 %1, %5, %2\n\tv_fma_f32 %0, %4, %2, -%0\n\tv_fma_f32 %1, %4, %3, %1" : "=&v"(rx), "=&v"(ry) : "v"(a.x), "v"(a.y), "s"(c), "s"(s));
    return cpx{rx, ry}; }
template <bool INV, int H_, int ES, int BLK, int I> __device__ __forceinline__ void stage_one(cpx (&v)[16]) { bfly<(I * ES) & 7, INV>(v[BLK + I], v[BLK + I + H_]); }
template <int E> __device__ __forceinline__ cpx mulw16(cpx a) {
    constexpr float C1 = 0.92387953251f, S1 = 0.38268343236f, H = 0.70710678118f; float qx, qy, t0, t1;
    if constexpr (E == 0) return a;
    else if constexpr (E == 4) return cpx{a.y, -a.x};
    else if constexpr (E == 2) { asm("v_add_f32 %2, %4, %5\n\tv_sub_f32 %3, %5, %4\n\tv_mul_f32 %0, %6, %2\n\tv_mul_f32 %1, %6, %3" : "=&v"(qx), "=&v"(qy), "=&v"(t0), "=&v"(t1) : "v"(a.x), "v"(a.y), "s"(H)); return cpx{qx, qy}; }
    else if constexpr (E == 6) { asm("v_sub_f32 %2, %5, %4\n\tv_add_f32 %3, %4, %5\n\tv_mul_f32 %0, %6, %2\n\tv_mul_f32 %1, %7, %3" : "=&v"(qx), "=&v"(qy), "=&v"(t0), "=&v"(t1) : "v"(a.x), "v"(a.y), "s"(H), "s"(-H)); return cpx{qx, qy}; }
    else { constexpr float c = E == 1 ? C1 : E == 3 ? S1 : E == 5 ? -S1 : -C1, sn = (E == 1 || E == 7) ? S1 : C1;
        asm("v_mul_f32 %0, %5, %3\n\tv_mul_f32 %1, %5, %2\n\tv_fma_f32 %0, %4, %2, %0\n\tv_fma_f32 %1, %4, %3, -%1" : "=&v"(qx), "=&v"(qy) : "v"(a.x), "v"(a.y), "s"(c), "s"(sn)); return cpx{qx, qy}; }
}
__device__ __forceinline__ void stage8_full(cpx (&v)[16]) { stage_one<false, 8, 1, 0, 0>(v); stage_one<false, 8, 1, 0, 1>(v); stage_one<false, 8, 1, 0, 2>(v); stage_one<false, 8, 1, 0, 3>(v);
    stage_one<false, 8, 1, 0, 4>(v); stage_one<false, 8, 1, 0, 5>(v); stage_one<false, 8, 1, 0, 6>(v); stage_one<false, 8, 1, 0, 7>(v); }
__device__ __forceinline__ void stage8_zero_hi(cpx (&v)[16]) { v[8] = mulw16<0>(v[0]); v[9] = mulw16<1>(v[1]); v[10] = mulw16<2>(v[2]); v[11] = mulw16<3>(v[3]); v[12] = mulw16<4>(v[4]); v[13] = mulw16<5>(v[5]); v[14] = mulw16<6>(v[6]); v[15] = mulw16<7>(v[7]); }
template <bool INV, int PRUNE = 0> __device__ __forceinline__ void dft16(cpx (&v)[16]) {
    if constexpr (PRUNE == 3) {   }
    else if constexpr (PRUNE == 1) { static_assert(!INV, "pruned first stage: forward only");
        v[8] = mulw16<0>(v[0]); v[9] = mulw16<1>(v[1]); v[10] = mulw16<2>(v[2]); v[11] = mulw16<3>(v[3]); v[12] = mulw16<4>(v[4]); v[13] = mulw16<5>(v[5]); v[14] = mulw16<6>(v[6]); v[15] = mulw16<7>(v[7]);
    } else {
#define HF_S8(I) stage_one<INV, 8, 1, 0, I>(v)
    HF_S8(0); HF_S8(1); HF_S8(2); HF_S8(3); HF_S8(4); HF_S8(5); HF_S8(6); HF_S8(7);
#undef HF_S8
    }
#define HF_S4(B, I) stage_one<INV, 4, 2, B, I>(v)
    HF_S4(0, 0); HF_S4(0, 1); HF_S4(0, 2); HF_S4(0, 3); HF_S4(8, 0); HF_S4(8, 1); HF_S4(8, 2); HF_S4(8, 3);
#define HF_S2(B) stage_one<INV, 2, 4, B, 0>(v); stage_one<INV, 2, 4, B, 1>(v)
    HF_S2(0); HF_S2(4); HF_S2(8); HF_S2(12);
    if constexpr (PRUNE == 2) {
#pragma unroll
        for (int b = 0; b < 16; b += 2) { float px, py; asm("v_add_f32 %0, %2, %4\n\tv_add_f32 %1, %3, %5" : "=&v"(px), "=&v"(py) : "v"(v[b].x), "v"(v[b].y), "v"(v[b + 1].x), "v"(v[b + 1].y)); v[b] = cpx{px, py}; }
    } else {
#define HF_S1(B) stage_one<INV, 1, 0, B, 0>(v)
    HF_S1(0); HF_S1(2); HF_S1(4); HF_S1(6); HF_S1(8); HF_S1(10); HF_S1(12); HF_S1(14);
#undef HF_S1
    }
#undef HF_S4
#undef HF_S2
    cpx t[16];
#pragma unroll
    for (int k = 0; k < 16; ++k) t[k] = v[((k & 1) << 3) | ((k & 2) << 1) | ((k & 4) >> 1) | ((k & 8) >> 3)];
#pragma unroll
    for (int k = 0; k < 16; ++k) v[k] = t[k];
}
__device__ __forceinline__ float dppx1(float x) { return __builtin_bit_cast(float, __builtin_amdgcn_update_dpp(0, __builtin_bit_cast(int, x), 0xB1, 0xf, 0xf, true)); }
struct Ctx {
    f32x2 t1[15];
    LAS const f32x2* t2;
    int b1, b2, b3;
    float sgn; bool odd;
};
__device__ __forceinline__ void init(Ctx& c, int tid, LAS f32x2* tab) {
#pragma unroll
    for (int k = 1; k < 16; ++k) { float s, co; sincosf(-6.283185307179586f * (float)((tid * k) & (N - 1)) * (1.0f / N), &s, &co); c.t1[k - 1] = (f32x2){co, s}; }
    if (tid < 480) { const int k = 1 + (tid >> 5), b = tid & 31; float s, co; sincosf(-6.283185307179586f * (float)(16 * b * k) * (1.0f / N), &s, &co); tab[tid] = (f32x2){co, s}; }
    c.t2 = tab + (tid & 31);
    c.b1 = 8 * (tid + 2 * (tid >> 5)); c.b2 = 8 * (544 * (tid >> 5) + (tid & 31)); c.b3 = 8 * (34 * (tid >> 1) + (tid & 1));
    c.odd = tid & 1; c.sgn = c.odd ? -1.0f : 1.0f;
}
constexpr float W32[16][2] = {{1.000000000f, -0.000000000f}, {0.980785280f, -0.195090322f}, {0.923879533f, -0.382683432f}, {0.831469612f, -0.555570233f}, {0.707106781f, -0.707106781f}, {0.555570233f, -0.831469612f},
    {0.382683432f, -0.923879533f}, {0.195090322f, -0.980785280f}, {0.000000000f, -1.000000000f}, {-0.195090322f, -0.980785280f}, {-0.382683432f, -0.923879533f}, {-0.555570233f, -0.831469612f},
    {-0.707106781f, -0.707106781f}, {-0.831469612f, -0.555570233f}, {-0.923879533f, -0.382683432f}, {-0.980785280f, -0.195090322f}};
template <int STEP> __device__ __forceinline__ void xw(LAS unsigned char* buf, int base, const cpx (&v)[16]) {
#pragma unroll
    for (int j = 0; j < 16; ++j) *(LAS f32x2*)(buf + base + j * STEP) = (f32x2){v[j].x, v[j].y};
}
template <int STEP> __device__ __forceinline__ void xw1(LAS unsigned char* buf, int base, int j, const cpx& v) { *(LAS f32x2*)(buf + base + j * STEP) = (f32x2){v.x, v.y}; }
template <int STEP> __device__ __forceinline__ void xr(LAS unsigned char* buf, int base, cpx (&v)[16]) {
#pragma unroll
    for (int j = 0; j < 16; ++j) { const f32x2 t = *(LAS const f32x2*)(buf + base + j * STEP); v[j] = cpx{t.x, t.y}; }
}
__device__ __forceinline__ void fwd(cpx (&v)[16], const Ctx& c, LAS unsigned char* bufA, LAS unsigned char* bufB, bool full_in) {
    if (full_in) stage8_full(v); else stage8_zero_hi(v);
    dft16<false, 3>(v);
    { xw1<4352>(bufA, c.b1, 0, v[0]);
#pragma unroll
      for (int k = 1; k < 16; ++k) { v[k] = cmulw<false>(v[k], c.t1[k - 1]); xw1<4352>(bufA, c.b1, k, v[k]); __builtin_amdgcn_sched_barrier(0); } }
    __syncthreads(); xr<272>(bufA, c.b2, v);
    dft16<false>(v);
    { f32x2 wn = c.t2[0]; xw1<272>(bufB, c.b2, 0, v[0]);
#pragma unroll
      for (int k = 1; k < 16; ++k) { const f32x2 w = wn; if (k < 15) wn = c.t2[32 * k]; v[k] = cmulw<false>(v[k], w); xw1<272>(bufB, c.b2, k, v[k]); __builtin_amdgcn_sched_barrier(0); } }
    xr<16>(bufB, c.b3, v);
    dft16<false>(v);
    cpx o[16];
#pragma unroll
    for (int k = 0; k < 16; ++k) { const cpx t = cmulk<false>(v[k], W32[k][0], W32[k][1]); o[k] = cpx{c.odd ? t.x : v[k].x, c.odd ? t.y : v[k].y}; }
    __builtin_amdgcn_sched_barrier(0);
#pragma unroll
    for (int k = 0; k < 16; ++k) v[k] = cpx{__builtin_fmaf(c.sgn, o[k].x, dppx1(o[k].x)), __builtin_fmaf(c.sgn, o[k].y, dppx1(o[k].y))};
}
__device__ __forceinline__ void inv(cpx (&v)[16], const Ctx& c, LAS unsigned char* bufA, LAS unsigned char* bufB) {
    cpx r[16];
#pragma unroll
    for (int k = 0; k < 16; ++k) r[k] = cpx{__builtin_fmaf(c.sgn, v[k].x, dppx1(v[k].x)), __builtin_fmaf(c.sgn, v[k].y, dppx1(v[k].y))};
    __builtin_amdgcn_sched_barrier(0);
#pragma unroll
    for (int k = 0; k < 16; ++k) { const cpx t = cmulk<true>(r[k], W32[k][0], W32[k][1]); v[k] = cpx{c.odd ? t.x : r[k].x, c.odd ? t.y : r[k].y}; }
    dft16<true>(v);
    xw<16>(bufB, c.b3, v); xr<272>(bufB, c.b2, v);
    {
#pragma unroll
      for (int k = 1; k < 16; ++k) v[k] = cmulw<true>(v[k], c.t2[32 * (k - 1)]); }
    dft16<true>(v);
    xw<272>(bufA, c.b2, v); __syncthreads(); xr<4352>(bufA, c.b1, v);
    {
#pragma unroll
      for (int k = 1; k < 16; ++k) v[k] = cmulw<true>(v[k], c.t1[k - 1]); }
    dft16<true, 2>(v);
}
__device__ __forceinline__ void specmul(cpx (&v)[16], const f32x2 (&K)[16]) {
#pragma unroll
    for (int k = 0; k < 16; ++k) { const float x = v[k].x * K[k].x - v[k].y * K[k].y, y = v[k].x * K[k].y + v[k].y * K[k].x; v[k] = cpx{x, y}; }
}
}
typedef __amdgpu_buffer_rsrc_t rsrc_t;
__device__ __forceinline__ rsrc_t seq_rsrc(const bf16* p, int bytes) { return __builtin_amdgcn_make_buffer_rsrc((void*)p, 0, bytes, 0x00020000); }
namespace hfft { constexpr int ROWB = 8192 + 32; }
struct RowPair { u32x4 a, b; };
__device__ __forceinline__ RowPair rows_issue(const bf16* r0, const bf16* r1, int tid) { RowPair p; p.a = *(const u32x4*)(r0 + 8 * tid); p.b = *(const u32x4*)(r1 + 8 * tid); return p; }
__device__ __forceinline__ void rows_park(LAS unsigned char* buf, const RowPair& p, int tid) {
    *(LAS u32x4*)(buf + 16 + 16 * tid) = p.a; *(LAS u32x4*)(buf + 16 + hfft::ROWB + 16 * tid) = p.b;
    if (tid < 2) { *(LAS unsigned*)(buf + 12 + tid * hfft::ROWB) = 0u; *(LAS unsigned*)(buf + 16 + 8192 + tid * hfft::ROWB) = 0u; }
}
__device__ __forceinline__ float rows_rd(LAS const unsigned char* p, int off) { return bf2f(*(LAS const unsigned short*)(p + off)); }
__device__ __forceinline__ float rows_sconv(LAS const unsigned char* p, int off, float w0, float w1, float w2, float cb) {
    const unsigned r0 = *(LAS const unsigned short*)(p + off), r1 = *(LAS const unsigned short*)(p + off + 2), r2 = *(LAS const unsigned short*)(p + off + 4);
    float y, t0, t1, t2;
    asm("v_lshlrev_b32 %1, 16, %4\n\tv_lshlrev_b32 %2, 16, %5\n\tv_lshlrev_b32 %3, 16, %6\n\tv_fma_f32 %0, %7, %1, %10\n\tv_fma_f32 %0, %8, %2, %0\n\tv_fma_f32 %0, %9, %3, %0"
        : "=&v"(y), "=&v"(t0), "=&v"(t1), "=&v"(t2) : "v"(r0), "v"(r1), "v"(r2), "s"(w0), "s"(w1), "s"(w2), "v"(cb));
    return y; }
__device__ __forceinline__ void hyena_fft(const Args& args, Frame& F, bool dry = false) {
    using namespace hfft;
    LAS unsigned char* bufA = F.lds; LAS unsigned char* bufB = F.lds + BUFB; LAS unsigned char* bufG = F.lds + 2 * BUFB;
    const float* cw = args.in[I_CW]; const float* cbv = args.in[I_CB];
    const int tid = F.tid;
    Ctx cx; init(cx, tid, (LAS f32x2*)(F.lds + 2 * BUFB + 16464)); __syncthreads();
    f32x2* KS = WSP(f32x2, WS_KS) + (size_t)F.bid * N;
    const bf16* TAP = WSP(bf16, WS_TAPL);
    RowPair pin, pg;
    { const int c0 = F.bid < 1024 ? F.bid : 0; pin = rows_issue(TAP + (size_t)c0 * 8192, TAP + (size_t)(1024 + c0) * 8192, tid); pg = rows_issue(TAP + (size_t)c0 * 8192 + 4096, TAP + (size_t)(1024 + c0) * 8192 + 4096, tid); }
#pragma unroll 1
    for (int c = F.bid; c < 1024; c += F.G) {
        bf16* r1 = WSP(bf16, WS_HYT) + NCTX + (size_t)c * MTOK; const bf16* r2 = r1 + (size_t)1024 * MTOK; bf16* r3 = r1 + (size_t)2048 * MTOK;
        const int cn = c + F.G < 1024 ? c + F.G : c;
        f32x2 K[16];
#pragma unroll 1
        for (int job = 0; job < 9; ++job) {
            const int sweep = job >= 5, bp = (job - 1) & 3;
            const size_t o0 = (size_t)(2 * bp) * LSEQ, o1 = o0 + LSEQ;
            if (job != 0) pg = sweep ? rows_issue(r2 + o0, r2 + o1, tid) : rows_issue(r1 + o0, r1 + o1, tid);
            const int cg = sweep * 1024 + c;
            const float wg0 = cw[cg], wg1 = cw[NHY + cg], wg2 = cw[2 * NHY + cg], bg = cbv[cg];
            rows_park(bufB, pin, tid);
            if (job == 0) rows_park(bufG, pg, tid);
            __syncthreads();
            { const int jn = job + 1;
              if (jn < 9) { const size_t on = (size_t)(2 * ((jn - 1) & 3)) * LSEQ; pin = rows_issue(r3 + on, r3 + on + LSEQ, tid); }
              else pin = rows_issue(TAP + (size_t)cn * 8192, TAP + (size_t)(1024 + cn) * 8192, tid); }
            int t2 = 2 * tid; asm volatile("" : "+v"(t2));
            LAS const unsigned char* pB = bufB + 14 + t2; LAS const unsigned char* pG = bufG + 14 + t2;
            cpx d[16];
            if (job == 0) {
                const float* p0 = WSP(float, WS_INVS) + (size_t)c * 2; const float* p1 = WSP(float, WS_INVS) + (size_t)(1024 + c) * 2;
                const float i0 = 1.0f / (p0[0] + p0[1] + EPSF), i1 = 1.0f / (p1[0] + p1[1] + EPSF), sk0 = args.in[I_HSKIP][c], sk1 = args.in[I_HSKIP][1024 + c];
                LAS const unsigned char* qB = bufB + 16 + 2 * (4095 - 3584) - t2; LAS const unsigned char* qG = bufG + 16 + 2 * (4095 - 3584) - t2;
#pragma unroll
                for (int j = 0; j < 16; ++j) { const int jj = j & 7; LAS const unsigned char* q = j < 8 ? qB : qG;
                    d[j] = cpx{rows_rd(q, 1024 * (7 - jj)) * i0, rows_rd(q, ROWB + 1024 * (7 - jj)) * i1};
                    if (j == 0 && tid == 0) { d[j].x += sk0; d[j].y += sk1; } }
            } else if (!sweep) {
                const float wv0 = cw[2048 + c], wv1 = cw[NHY + 2048 + c], wv2 = cw[2 * NHY + 2048 + c], bv = cbv[2048 + c];
#pragma unroll
                for (int j = 0; j < 8; ++j) { d[j] = cpx{rows_sconv(pB, 1024 * j, wv0, wv1, wv2, bv), rows_sconv(pB, ROWB + 1024 * j, wv0, wv1, wv2, bv)}; d[j + 8] = cpx{0.f, 0.f}; }
            } else {
#pragma unroll
                for (int j = 0; j < 8; ++j) { d[j] = cpx{rows_rd(pB, 1024 * j + 2), rows_rd(pB, ROWB + 1024 * j + 2)}; d[j + 8] = cpx{0.f, 0.f}; }
            }
            fwd(d, cx, bufA, bufB, job == 0);
            if (job == 0) {
                LAS f32x2* xb = (LAS f32x2*)bufA;
                __syncthreads();
#pragma unroll
                for (int k = 0; k < 16; ++k) xb[k * 512 + tid] = (f32x2){d[k].x, d[k].y};
                __syncthreads();
                const int fbase = (tid >> 5) + 16 * ((tid >> 1) & 15) + 4096 * (tid & 1); const float sc = 0.5f / (float)N;
#pragma unroll
                for (int k = 0; k < 16; ++k) { const int f = fbase + 256 * k, fp = (N - f) & (N - 1), tp = 32 * (fp & 15) + 2 * ((fp >> 4) & 15) + (fp >> 12), kp = (fp >> 8) & 15;
                    const f32x2 xp = xb[kp * 512 + tp];
                    K[k] = (f32x2){(d[k].x + xp.x) * sc, (d[k].y - xp.y) * sc};
                    KS[k * 512 + tid] = (f32x2){(d[k].y + xp.y) * sc, (xp.x - d[k].x) * sc}; }
            } else {
                specmul(d, K);
                if (job == 4) {
#pragma unroll
                    for (int k = 0; k < 16; ++k) K[k] = KS[k * 512 + tid]; }
                rows_park(bufG, pg, tid);
                if (job == 8) pg = rows_issue(TAP + (size_t)cn * 8192 + 4096, TAP + (size_t)(1024 + cn) * 8192 + 4096, tid);
                inv(d, cx, bufA, bufB);
                const rsrc_t q0 = seq_rsrc((sweep ? r1 : r3) + o0, 8192), q1 = seq_rsrc((sweep ? r1 : r3) + o1, 8192);
#pragma unroll
                for (int j = 0; j < 8; ++j) { const int t = tid + 512 * j;
                    const float y0 = rows_sconv(pG, 1024 * j, wg0, wg1, wg2, bg) * d[j].x;
                    const float y1 = rows_sconv(pG, ROWB + 1024 * j, wg0, wg1, wg2, bg) * d[j].y;
                    unsigned yp; asm("v_cvt_pk_bf16_f32 %0, %1, %2" : "=v"(yp) : "v"(y0), "v"(y1));
                    if (!dry) { __builtin_amdgcn_raw_buffer_store_b16((short)(yp & 0xffffu), q0, 2 * t, 0, 0); __builtin_amdgcn_raw_buffer_store_b16((short)(yp >> 16), q1, 2 * t, 0, 0); } }
            }
        }
        __syncthreads();
    }
}
__device__ __forceinline__ void hy_transpose(const Args& args, Frame& F) {
    LAS unsigned char* tile = F.lds + F.wave * 8192;
    const int gw = F.bid * NWAVES + F.wave, NGW = F.G * NWAVES, lane = F.lane, ch8 = lane & 7, rq = lane >> 3;
    const bf16* src = WSP(bf16, WS_HYT); bf16* dst = WSP(bf16, WS_HYO);
    for (int it = gw; it < (1024 / 64) * (MTOK / 64); it += NGW) {
        const int cb = it % 16, mb = it / 16;
        u32x4 v[8];
#pragma unroll
        for (int i = 0; i < 8; ++i) v[i] = *(const u32x4*)(src + (size_t)(cb * 64 + rq + 8 * i) * MTOK + mb * 64 + ch8 * 8);
#pragma unroll
        for (int i = 0; i < 8; ++i) *(LAS u32x4*)(tile + (rq + 8 * i) * 128 + ((ch8 ^ i) * 16)) = v[i];
        LDS_WAIT(); asm volatile("" ::: "memory");
#pragma unroll
        for (int i = 0; i < 8; ++i) { const int tok = rq + 8 * i;
            unsigned short e[8];
#pragma unroll
            for (int j = 0; j < 8; ++j) e[j] = *(LAS const unsigned short*)(tile + (ch8 * 8 + j) * 128 + ((i ^ ch8) * 16) + (tok & 7) * 2);
            u32x4 o; o.x = e[0] | ((unsigned)e[1] << 16); o.y = e[2] | ((unsigned)e[3] << 16); o.z = e[4] | ((unsigned)e[5] << 16); o.w = e[6] | ((unsigned)e[7] << 16);
            *(u32x4*)(dst + (size_t)(mb * 64 + tok) * DM + cb * 64 + ch8 * 8) = o; }
        LDS_WAIT(); asm volatile("" ::: "memory");
    }
}
struct EpiGates { bf16* GA; bf16* GH; __device__ __forceinline__ void operator()(int row, int col, float v, float) const {
    const unsigned s = f2bf(sigmoidf_(v)); if (col < DM) GA[(size_t)row * DM + col] = (bf16)s; else GH[(size_t)row * DM + col - DM] = (bf16)s; } };
struct EpiMA { const bf16* GA; bf16* MA; __device__ __forceinline__ void operator()(int row, int col, float v, float) const { MA[(size_t)row * DM + col] = (bf16)f2bf(bf2f(GA[(size_t)row * DM + col]) * v); } };
struct EpiMerged { const bf16* GH; const bf16* MA; bf16* O; __device__ __forceinline__ void operator()(int row, int col, float v, float) const {
    O[(size_t)row * DM + col] = (bf16)f2bf(bf2f(MA[(size_t)row * DM + col]) + bf2f(GH[(size_t)row * DM + col]) * v); } };

namespace pg8 {
#define PG8_LAS __attribute__((address_space(3)))
typedef unsigned short bf16_t;
typedef short bf16x8 __attribute__((ext_vector_type(8)));
typedef float f32x4 __attribute__((ext_vector_type(4)));
typedef unsigned u32x4 __attribute__((ext_vector_type(4)));
constexpr int BM = 256, BK = 64, HALF = 128, HTB = HALF * BK * 2  , STAGE_BYTES = 8 * HTB, NXCD = 8, WGM = 8;
__host__ __device__ __forceinline__ int lds_byte(int r, int c) { const int st = (r >> 4) * 2 + (c >> 5), rr = r & 15, cc = c & 31, ob = rr * 64 + cc * 2; return st * 1024 + (ob ^ (((ob >> 9) & 1) << 5)); }
__host__ __device__ __forceinline__ void stage_rc(int b, int& R, int& C) { const int st = b / 1024, sb = b % 1024, swz = sb ^ (((sb >> 9) & 1) << 5); R = (st >> 1) * 16 + swz / 64; C = (st & 1) * 32 + (swz % 64) / 2; }
__host__ __device__ __forceinline__ int perm32(int rho) { const int n = rho >> 4, i = rho & 15; return 8 * (i >> 2) + 4 * n + (i & 3); }
struct Unit { int pm, pn; };
struct Gemm { const bf16_t* A; const bf16_t* Bt; int M, N, K; };
struct StaticOrder {
    int nM, nN, nwg, G, c;
    __host__ __device__ void init(int M, int N, int G_, int c_, int TM = BM) { nM = M / TM; nN = N / BM; nwg = nM * nN; G = G_; c = c_; }
    __host__ __device__ bool next(int i, Unit& u) const {
        const long L = (long)i * G + c; if (L >= nwg) return false;
        int wgid = (int)L; { const int q = nwg / NXCD, r = nwg % NXCD, xcd = wgid % NXCD, off = wgid / NXCD; wgid = (xcd < r ? xcd * (q + 1) : r * (q + 1) + (xcd - r) * q) + off; }
        const int nig = WGM * nN, gid = wgid / nig, fm = gid * WGM, gsz = (nM - fm) < WGM ? (nM - fm) : WGM;
        u.pm = fm + ((wgid % nig) % gsz); u.pn = (wgid % nig) / gsz; return true;
    }
    __device__ __forceinline__ void a_ready(const Unit&) const {}
    __device__ __forceinline__ void done(const Unit&) const {}
};
typedef float f32x2_t __attribute__((ext_vector_type(2))); typedef __bf16 bf16x2_t __attribute__((ext_vector_type(2)));
__device__ __forceinline__ unsigned cvt_pk_bf16(float lo, float hi) { f32x2_t v = {lo, hi}; bf16x2_t b = __builtin_convertvector(v, bf16x2_t); return __builtin_bit_cast(unsigned, b); }
template <class Epi, class Sched, bool ALIGN_EPI = false, bool SP2 = false, int MF = 4>
__device__ __forceinline__ void gemm_phase(PG8_LAS unsigned char* lds, const Gemm g, const Sched& S, const Epi& E) {
    const int tid = threadIdx.x, wid = __builtin_amdgcn_readfirstlane(tid >> 6), lane = tid & 63, wr = wid >> 2, wc = wid & 3, fr = lane & 15, fq = lane >> 4;
    const int K = g.K, nt = K / BK;
    unsigned voffA[2], voffB[2];
#pragma unroll
    for (int i = 0; i < 2; ++i) { int R, C; stage_rc(tid * 16 + i * 8192, R, C); const int Rb = Epi::PERM ? ((R & ~31) + perm32(R & 31)) : R;
        voffA[i] = (unsigned)(R * K + C) * 2u; voffB[i] = (unsigned)(Rb * K + C) * 2u; }
    const size_t kstep = (size_t)(BK * 2);
    const size_t hstepA = (size_t)(32 * MF) * K * 2, hstepB = (size_t)HALF * K * 2;
    const size_t tstepA = 2 * hstepA, tstepB = 2 * hstepB;
    const unsigned ldsw = (unsigned)wid * 1024u;
    const int aoff = lds_byte(wr * (16 * MF) + fr, fq * 8), boff = lds_byte(wc * 32 + fr, fq * 8);
#define PG8_SA(b, h) (((b) * 2 + (h)) * HTB)
#define PG8_SB(b, h) ((4 + (b) * 2 + (h)) * HTB)
#define PG8_STAGE(bufoff, gbase, voff) do { _Pragma("unroll") for (int _i = 0; _i < 2; ++_i) \
        __builtin_amdgcn_global_load_lds((const unsigned*)((const char*)(gbase) + (voff)[_i]), (PG8_LAS unsigned*)(lds + (bufoff) + ldsw + _i * 8192), 16, 0, 0); } while (0)
#define PG8_LDA(dst, b, h) do { _Pragma("unroll") for (int m = 0; m < MF; ++m) _Pragma("unroll") for (int k = 0; k < 2; ++k) dst[m][k] = *(const PG8_LAS bf16x8*)(lds + PG8_SA(b, h) + aoff + m * 2048 + k * 1024); } while (0)
#define PG8_LDB(dst, b, h) do { _Pragma("unroll") for (int n = 0; n < 2; ++n) _Pragma("unroll") for (int k = 0; k < 2; ++k) dst[n][k] = *(const PG8_LAS bf16x8*)(lds + PG8_SB(b, h) + boff + n * 2048 + k * 1024); } while (0)
#define PG8_MMA(ai, bj, At, Bt) do { __builtin_amdgcn_s_setprio(1); _Pragma("unroll") for (int m = 0; m < MF; ++m) _Pragma("unroll") for (int n = 0; n < 2; ++n) _Pragma("unroll") for (int k = 0; k < 2; ++k) \
        acc[ai][bj][m][n] = __builtin_amdgcn_mfma_f32_16x16x32_bf16(Bt[n][k], At[m][k], acc[ai][bj][m][n], 0, 0, 0); __builtin_amdgcn_s_setprio(0); } while (0)
#define PG8_WAIT_V(n) asm volatile("s_waitcnt vmcnt(" #n ")" ::: "memory")
#define PG8_WAIT_L(n) asm volatile("s_waitcnt lgkmcnt(" #n ")" ::: "memory")
#define PG8_BAR __builtin_amdgcn_s_barrier()
#define PG8_SCHED __builtin_amdgcn_sched_barrier(0)
    Unit cur, nxt; int ui = 0;
    if (!S.next(0, cur)) return;
    f32x4 acc[2][2][MF][2];
#pragma unroll
    for (int a = 0; a < 2; ++a)
#pragma unroll
        for (int b = 0; b < 2; ++b)
#pragma unroll
            for (int m = 0; m < MF; ++m)
#pragma unroll
                for (int n = 0; n < 2; ++n) acc[a][b][m][n] = (f32x4){0.f, 0.f, 0.f, 0.f};
    bf16x8 At[MF][2], B0[2][2], B1[2][2];
    const char* cA = (const char*)g.A + (size_t)cur.pm * tstepA; const char* cB = (const char*)g.Bt + (size_t)cur.pn * tstepB;
    S.a_ready(cur);
    if constexpr (SP2) {
        PG8_STAGE(PG8_SB(0, 0), cB, voffB); PG8_STAGE(PG8_SB(0, 1), cB + hstepB, voffB); PG8_STAGE(PG8_SA(0, 0), cA, voffA); PG8_STAGE(PG8_SA(0, 1), cA + hstepA, voffA);
        if (wr == 1) PG8_BAR;
        PG8_WAIT_V(2); PG8_BAR;
        PG8_STAGE(PG8_SB(1, 0), cB + kstep, voffB); PG8_STAGE(PG8_SA(1, 0), cA + kstep, voffA); PG8_STAGE(PG8_SB(1, 1), cB + hstepB + kstep, voffB);
        PG8_WAIT_V(6); PG8_BAR;
    } else {
        PG8_STAGE(PG8_SB(0, 0), cB, voffB); PG8_STAGE(PG8_SA(0, 0), cA, voffA); PG8_STAGE(PG8_SB(0, 1), cB + hstepB, voffB); PG8_STAGE(PG8_SA(0, 1), cA + hstepA, voffA);
        if (wr == 1) PG8_BAR;
        PG8_WAIT_V(4); PG8_BAR;
        PG8_STAGE(PG8_SB(1, 0), cB + kstep, voffB); PG8_STAGE(PG8_SA(1, 0), cA + kstep, voffA); PG8_STAGE(PG8_SB(1, 1), cB + hstepB + kstep, voffB);
        PG8_WAIT_V(6); PG8_BAR;
    }
    for (;;) {
        const bool has_next = S.next(ui + 1, nxt);
        const char* nA = has_next ? (const char*)g.A + (size_t)nxt.pm * tstepA : cA; const char* nB = has_next ? (const char*)g.Bt + (size_t)nxt.pn * tstepB : cB;
        for (int t = 0; t < nt; t += 2) {
            const bool last = (t == nt - 2);
            const char* a1 = cA + (size_t)(t + 1) * kstep;
            const char* a2 = last ? nA : cA + (size_t)(t + 2) * kstep; const char* b2 = last ? nB : cB + (size_t)(t + 2) * kstep;
            const char* a3 = a2 + kstep; const char* b3 = b2 + kstep;
            if (last && has_next) S.a_ready(nxt);
            if constexpr (SP2) {
            PG8_LDB(B0, 0, 0); PG8_LDB(B1, 0, 1); PG8_SCHED; PG8_LDA(At, 0, 0); PG8_STAGE(PG8_SA(1, 1), a1 + hstepA, voffA);
            PG8_WAIT_V(8); PG8_WAIT_L(0); PG8_BAR; PG8_MMA(0, 0, At, B0); PG8_MMA(0, 1, At, B1); PG8_BAR; PG8_SCHED;
            PG8_LDA(At, 0, 1); PG8_STAGE(PG8_SB(0, 0), b2, voffB); PG8_STAGE(PG8_SB(0, 1), b2 + hstepB, voffB); PG8_STAGE(PG8_SA(0, 0), a2, voffA);
            PG8_WAIT_V(8); PG8_WAIT_L(0); PG8_BAR; PG8_MMA(1, 0, At, B0); PG8_MMA(1, 1, At, B1); PG8_BAR; PG8_SCHED;
            PG8_LDB(B0, 1, 0); PG8_LDB(B1, 1, 1); PG8_SCHED; PG8_LDA(At, 1, 0); PG8_STAGE(PG8_SA(0, 1), a2 + hstepA, voffA);
            PG8_WAIT_V(8); PG8_WAIT_L(0); PG8_BAR; PG8_MMA(0, 0, At, B0); PG8_MMA(0, 1, At, B1); PG8_BAR; PG8_SCHED;
            PG8_LDA(At, 1, 1); PG8_STAGE(PG8_SB(1, 0), b3, voffB); PG8_STAGE(PG8_SB(1, 1), b3 + hstepB, voffB); PG8_STAGE(PG8_SA(1, 0), a3, voffA);
            PG8_WAIT_V(8); PG8_WAIT_L(0); PG8_BAR; PG8_MMA(1, 0, At, B0); PG8_MMA(1, 1, At, B1); PG8_BAR; PG8_SCHED;
            } else {
            PG8_LDB(B0, 0, 0); PG8_SCHED; PG8_LDA(At, 0, 0); PG8_STAGE(PG8_SA(1, 1), a1 + hstepA, voffA);
            PG8_WAIT_L(8); PG8_BAR; PG8_WAIT_L(0); PG8_MMA(0, 0, At, B0); PG8_BAR; PG8_SCHED;
            PG8_LDB(B1, 0, 1); PG8_STAGE(PG8_SB(0, 0), b2, voffB);
            PG8_BAR; PG8_WAIT_L(0); PG8_MMA(0, 1, At, B1); PG8_BAR;
            PG8_LDA(At, 0, 1); PG8_STAGE(PG8_SA(0, 0), a2, voffA);
            PG8_BAR; PG8_WAIT_L(0); PG8_MMA(1, 0, At, B0); PG8_BAR; PG8_SCHED;
            PG8_STAGE(PG8_SB(0, 1), b2 + hstepB, voffB);
            PG8_WAIT_V(6); PG8_BAR; PG8_MMA(1, 1, At, B1); PG8_BAR;
            PG8_LDB(B0, 1, 0); PG8_SCHED; PG8_LDA(At, 1, 0); PG8_STAGE(PG8_SA(0, 1), a2 + hstepA, voffA);
            PG8_WAIT_L(8); PG8_BAR; PG8_WAIT_L(0); PG8_MMA(0, 0, At, B0); PG8_BAR; PG8_SCHED;
            PG8_LDB(B1, 1, 1); PG8_STAGE(PG8_SB(1, 0), b3, voffB);
            PG8_BAR; PG8_WAIT_L(0); PG8_MMA(0, 1, At, B1); PG8_BAR;
            PG8_LDA(At, 1, 1); PG8_STAGE(PG8_SA(1, 0), a3, voffA);
            PG8_BAR; PG8_WAIT_L(0); PG8_MMA(1, 0, At, B0); PG8_BAR; PG8_SCHED;
            PG8_STAGE(PG8_SB(1, 1), b3 + hstepB, voffB);
            PG8_WAIT_V(6); PG8_BAR; PG8_MMA(1, 1, At, B1); PG8_BAR;
            }
        }
        if constexpr (ALIGN_EPI) { if (wr == 0) PG8_BAR; }
        if constexpr (!Epi::AFTER_DRAIN) { E(acc, cur, wr, wc, fr, fq); S.done(cur); }
        if (!has_next) break;
#pragma unroll
        for (int a = 0; a < 2; ++a)
#pragma unroll
            for (int b = 0; b < 2; ++b)
#pragma unroll
                for (int m = 0; m < MF; ++m)
#pragma unroll
                    for (int n = 0; n < 2; ++n) acc[a][b][m][n] = (f32x4){0.f, 0.f, 0.f, 0.f};
        cur = nxt; cA = nA; cB = nB; ++ui;
        if constexpr (ALIGN_EPI) { if (wr == 1) PG8_BAR; }
    }
    PG8_WAIT_V(0);
    if constexpr (!ALIGN_EPI) { if (wr == 0) PG8_BAR; }
    PG8_BAR;
    if constexpr (Epi::AFTER_DRAIN) { E.fused(acc, cur, wr, wc, fr, fq, lds, wid, lane); S.done(cur); }
#undef PG8_SA
#undef PG8_SB
#undef PG8_STAGE
#undef PG8_LDA
#undef PG8_LDB
#undef PG8_MMA
#undef PG8_WAIT_V
#undef PG8_WAIT_L
#undef PG8_BAR
#undef PG8_SCHED
}
}

namespace pg8 {
typedef unsigned u32x2 __attribute__((ext_vector_type(2)));
__device__ __forceinline__ float silu_f(float g) { return g * __builtin_amdgcn_rcpf(1.0f + __expf(-g)); }
__device__ __forceinline__ float sigm_f(float g) { return __builtin_amdgcn_rcpf(1.0f + __expf(-g)); }
__device__ __forceinline__ float bflo(unsigned w) { return __builtin_bit_cast(float, w << 16); }
__device__ __forceinline__ float bfhi(unsigned w) { return __builtin_bit_cast(float, w & 0xffff0000u); }
struct EpiBf16P { static constexpr bool PERM = true, AFTER_DRAIN = false; bf16_t* O; int ldc;
    __device__ __forceinline__ void operator()(const f32x4 (&acc)[2][2][4][2], const Unit& u, int wr, int wc, int fr, int fq) const {
        const int row0 = u.pm * BM + wr * 64 + fr, col0 = u.pn * BM + wc * 32 + 8 * fq;
#pragma unroll
        for (int ai = 0; ai < 2; ++ai)
#pragma unroll
            for (int m = 0; m < 4; ++m) { bf16_t* rowp = O + (size_t)(row0 + ai * HALF + m * 16) * ldc + col0;
#pragma unroll
                for (int bj = 0; bj < 2; ++bj) { const f32x4 v0 = acc[ai][bj][m][0], v1 = acc[ai][bj][m][1];
                    u32x4 w; w.x = cvt_pk_bf16(v0[0], v0[1]); w.y = cvt_pk_bf16(v0[2], v0[3]); w.z = cvt_pk_bf16(v1[0], v1[1]); w.w = cvt_pk_bf16(v1[2], v1[3]);
                    *(u32x4*)(rowp + bj * HALF) = w; } }
    }
};
struct EpiSwigluF { static constexpr bool PERM = true, AFTER_DRAIN = false; bf16_t* U;
    __device__ __forceinline__ void operator()(const f32x4 (&acc)[2][2][4][2], const Unit& u, int wr, int wc, int fr, int fq) const {
        const int row0 = u.pm * BM + wr * 64 + fr, col0 = u.pn * HALF + wc * 32 + 8 * fq;
#pragma unroll
        for (int ai = 0; ai < 2; ++ai)
#pragma unroll
            for (int m = 0; m < 4; ++m) { bf16_t* rowp = U + (size_t)(row0 + ai * HALF + m * 16) * DFF + col0;
                const f32x4 g0 = acc[ai][0][m][0], g1 = acc[ai][0][m][1], u0 = acc[ai][1][m][0], u1 = acc[ai][1][m][1];
                u32x4 w; w.x = cvt_pk_bf16(silu_f(g0[0]) * u0[0], silu_f(g0[1]) * u0[1]); w.y = cvt_pk_bf16(silu_f(g0[2]) * u0[2], silu_f(g0[3]) * u0[3]);
                w.z = cvt_pk_bf16(silu_f(g1[0]) * u1[0], silu_f(g1[1]) * u1[1]); w.w = cvt_pk_bf16(silu_f(g1[2]) * u1[2], silu_f(g1[3]) * u1[3]);
                *(u32x4*)rowp = w; }
    }
};
template <bool FROM_IN> struct EpiResF { static constexpr bool PERM = false, AFTER_DRAIN = false;
    const float* xp; const float* xs; float* out; const float* mod; int goff; float coef;
    __device__ __forceinline__ void operator()(const f32x4 (&acc)[2][2][4][2], const Unit& u, int wr, int wc, int fr, int fq) const {
        const int row0 = u.pm * BM + wr * 64 + fr, col0 = u.pn * BM + wc * 32 + 4 * fq;
        const float* g = mod + mod_row(u.pm * BM) * MODW + goff + col0;
        f32x4 gv[2][2];
#pragma unroll
        for (int bj = 0; bj < 2; ++bj)
#pragma unroll
            for (int n = 0; n < 2; ++n) gv[bj][n] = *(const f32x4*)(g + bj * HALF + n * 16) * coef;
        const float* src = FROM_IN ? (u.pm * BM < NCTX ? xp + (size_t)row0 * DM : xs + (size_t)(row0 - NCTX) * DM) : out + (size_t)row0 * DM;
        float* dst = out + (size_t)row0 * DM;
#pragma unroll
        for (int ai = 0; ai < 2; ++ai)
#pragma unroll
            for (int m = 0; m < 4; ++m) { const size_t ro = (size_t)(ai * HALF + m * 16) * DM + col0;
#pragma unroll
                for (int bj = 0; bj < 2; ++bj)
#pragma unroll
                    for (int n = 0; n < 2; ++n) { const f32x4 x = *(const f32x4*)(src + ro + bj * HALF + n * 16); *(f32x4*)(dst + ro + bj * HALF + n * 16) = x + gv[bj][n] * acc[ai][bj][m][n]; }
                asm volatile("" ::: "memory"); }
    }
};
template <bool FROM_IN> struct EpiResF3 { static constexpr bool PERM = false, AFTER_DRAIN = false;
    const float* xp; const float* xs; float* out; const float* mod; int goff; float coef;
    __device__ __forceinline__ void operator()(const f32x4 (&acc)[2][2][3][2], const Unit& u, int wr, int wc, int fr, int fq) const {
        const int row0 = u.pm * 192 + wr * 48 + fr, col0 = u.pn * BM + wc * 32 + 4 * fq;
#pragma unroll
        for (int ai = 0; ai < 2; ++ai)
#pragma unroll
            for (int m = 0; m < 3; ++m) { const int row = row0 + ai * 96 + m * 16;
                const float* g = mod + mod_row(row) * MODW + goff + col0;
                const float* src = (FROM_IN ? (row < NCTX ? xp + (size_t)row * DM : xs + (size_t)(row - NCTX) * DM) : out + (size_t)row * DM) + col0;
                float* dst = out + (size_t)row * DM + col0;
#pragma unroll
                for (int bj = 0; bj < 2; ++bj)
#pragma unroll
                    for (int n = 0; n < 2; ++n) { const f32x4 gv = *(const f32x4*)(g + bj * HALF + n * 16) * coef, x = *(const f32x4*)(src + bj * HALF + n * 16);
                        *(f32x4*)(dst + bj * HALF + n * 16) = x + gv * acc[ai][bj][m][n]; }
                asm volatile("" ::: "memory"); }
    }
};
template <int SRC, bool DSTF> struct EpiResB3 { static constexpr bool PERM = true, AFTER_DRAIN = false;
    const float* xp; const float* xs; const bf16_t* xb; bf16_t* ob; float* of; const float* mod; int goff; float coef;
    __device__ __forceinline__ void operator()(const f32x4 (&acc)[2][2][3][2], const Unit& u, int wr, int wc, int fr, int fq) const {
        const int row0 = u.pm * 192 + wr * 48 + fr, col0 = u.pn * BM + wc * 32 + 8 * fq;
#pragma unroll
        for (int ai = 0; ai < 2; ++ai)
#pragma unroll
            for (int m = 0; m < 3; ++m) { const int row = row0 + ai * 96 + m * 16;
                const float* g = mod + mod_row(row) * MODW + goff + col0;
                const size_t ro = (size_t)row * DM + col0;
                const float* srcf = (row < NCTX ? xp + (size_t)row * DM : xs + (size_t)(row - NCTX) * DM) + col0;
#pragma unroll
                for (int bj = 0; bj < 2; ++bj) {
                    const f32x4 g0 = *(const f32x4*)(g + bj * HALF) * coef, g1 = *(const f32x4*)(g + bj * HALF + 4) * coef;
                    f32x4 x0, x1;
                    if (SRC == 0) { x0 = *(const f32x4*)(srcf + bj * HALF); x1 = *(const f32x4*)(srcf + bj * HALF + 4); }
                    else { const u32x4 p = *(const u32x4*)(xb + ro + bj * HALF); x0 = (f32x4){bflo(p.x), bfhi(p.x), bflo(p.y), bfhi(p.y)}; x1 = (f32x4){bflo(p.z), bfhi(p.z), bflo(p.w), bfhi(p.w)}; }
                    const f32x4 y0 = x0 + g0 * acc[ai][bj][m][0], y1 = x1 + g1 * acc[ai][bj][m][1];
                    if (DSTF) { *(f32x4*)(of + ro + bj * HALF) = y0; *(f32x4*)(of + ro + bj * HALF + 4) = y1; }
                    else { u32x4 w; w.x = cvt_pk_bf16(y0[0], y0[1]); w.y = cvt_pk_bf16(y0[2], y0[3]); w.z = cvt_pk_bf16(y1[0], y1[1]); w.w = cvt_pk_bf16(y1[2], y1[3]); *(u32x4*)(ob + ro + bj * HALF) = w; } }
                asm volatile("" ::: "memory"); }
    }
};
struct EpiQKVF { static constexpr bool PERM = false, AFTER_DRAIN = false;
    bf16_t *Q, *KC, *KL, *VC, *VL; float* nk; float* nv; const float* qn; const float* kn; const float* rope;
    __device__ __forceinline__ void operator()(const f32x4 (&acc)[2][2][4][2], const Unit& u, int wr, int wc, int fr, int fq) const {
        const int row0 = u.pm * BM + wr * 64 + fr; const bool lat = u.pm * BM >= NCTX;
        if (u.pn == 5) {
#pragma unroll
            for (int ai = 0; ai < 2; ++ai)
#pragma unroll
                for (int m = 0; m < 4; ++m) { const int row = row0 + ai * HALF + m * 16, t = (row - NCTX) & (LSEQ - 1), bl = (row - NCTX) >> 12;
                    bf16_t* dst = (lat ? VL + ((size_t)bl * KLROWS + PAST + t) * KVW : VC + (size_t)row * KVW) + wc * 32 + 4 * fq;
#pragma unroll
                    for (int bj = 0; bj < 2; ++bj)
#pragma unroll
                        for (int n = 0; n < 2; ++n) { const f32x4 v = acc[ai][bj][m][n]; u32x2 w; w.x = cvt_pk_bf16(v[0], v[1]); w.y = cvt_pk_bf16(v[2], v[3]);
                            *(u32x2*)(dst + bj * HALF + n * 16) = w;
                            if (!lat) *(f32x4*)(nv + (size_t)row * KVW + wc * 32 + 4 * fq + bj * HALF + n * 16) = v; } }
            return;
        }
        const bool isq = u.pn < 4; const float* nw = isq ? qn : kn;
        f32x4 w4[2][2];
#pragma unroll
        for (int bj = 0; bj < 2; ++bj)
#pragma unroll
            for (int n = 0; n < 2; ++n) w4[bj][n] = *(const f32x4*)(nw + 32 * bj + 16 * n + 4 * fq);
#pragma unroll
        for (int ai = 0; ai < 2; ++ai)
#pragma unroll
            for (int m = 0; m < 4; ++m) { const int row = row0 + ai * HALF + m * 16, t = (row - NCTX) & (LSEQ - 1), bl = (row - NCTX) >> 12;
                f32x4 v[2][2]; float ss = 0.f;
#pragma unroll
                for (int bj = 0; bj < 2; ++bj)
#pragma unroll
                    for (int n = 0; n < 2; ++n) { v[bj][n] = acc[ai][bj][m][n]; ss += (v[bj][n][0] * v[bj][n][0] + v[bj][n][1] * v[bj][n][1]) + (v[bj][n][2] * v[bj][n][2] + v[bj][n][3] * v[bj][n][3]); }
                ss += __shfl_xor(ss, 16); ss += __shfl_xor(ss, 32);
                const float rs = 1.0f / sqrtf(ss * (1.0f / 64.0f) + EPSF);
#pragma unroll
                for (int bj = 0; bj < 2; ++bj)
#pragma unroll
                    for (int n = 0; n < 2; ++n) v[bj][n] = v[bj][n] * rs * w4[bj][n];
                if (!isq && !lat) {
#pragma unroll
                    for (int bj = 0; bj < 2; ++bj)
#pragma unroll
                        for (int n = 0; n < 2; ++n) *(f32x4*)(nk + (size_t)row * KVW + wc * 64 + 32 * bj + 16 * n + 4 * fq) = v[bj][n];
                }
                if (lat) {
#pragma unroll
                    for (int bj = 0; bj < 2; ++bj) { const int pos = bj ? (t & 63) : (t >> 6);
                        const f32x4* rp = (const f32x4*)(rope + (pos * 16 + 4 * fq) * 2); const f32x4 r0 = rp[0], r1 = rp[1];
                        const f32x4 cs = {r0[0], r0[2], r1[0], r1[2]}, sn = {r0[1], r0[3], r1[1], r1[3]};
                        const f32x4 x1 = v[bj][0], x2 = v[bj][1];
                        v[bj][0] = x1 * cs - x2 * sn; v[bj][1] = x2 * cs + x1 * sn; }
                }
                bf16_t* dst; float sc = 1.0f;
                if (isq) { dst = Q + (size_t)row * DM + (4 * u.pn + wc) * 64; sc = C2; }
                else dst = (lat ? KL + ((size_t)bl * KLROWS + PAST + t) * KVW : KC + (size_t)row * KVW) + wc * 64;
#pragma unroll
                for (int bj = 0; bj < 2; ++bj)
#pragma unroll
                    for (int n = 0; n < 2; ++n) { const f32x4 x = v[bj][n] * sc; u32x2 w; w.x = cvt_pk_bf16(x[0], x[1]); w.y = cvt_pk_bf16(x[2], x[3]);
                        *(u32x2*)(dst + 32 * bj + 16 * n + 4 * fq) = w; }
            }
    }
};
struct EpiGatesF { static constexpr bool PERM = true, AFTER_DRAIN = false; bf16_t* GA; bf16_t* GH;
    __device__ __forceinline__ void operator()(const f32x4 (&acc)[2][2][4][2], const Unit& u, int wr, int wc, int fr, int fq) const {
        const int row0 = u.pm * BM + wr * 64 + fr, col0 = (u.pn & 3) * BM + wc * 32 + 8 * fq; bf16_t* O = u.pn < 4 ? GA : GH;
#pragma unroll
        for (int ai = 0; ai < 2; ++ai)
#pragma unroll
            for (int m = 0; m < 4; ++m) { bf16_t* rowp = O + (size_t)(row0 + ai * HALF + m * 16) * DM + col0;
#pragma unroll
                for (int bj = 0; bj < 2; ++bj) { const f32x4 v0 = acc[ai][bj][m][0], v1 = acc[ai][bj][m][1];
                    u32x4 w; w.x = cvt_pk_bf16(sigm_f(v0[0]), sigm_f(v0[1])); w.y = cvt_pk_bf16(sigm_f(v0[2]), sigm_f(v0[3])); w.z = cvt_pk_bf16(sigm_f(v1[0]), sigm_f(v1[1])); w.w = cvt_pk_bf16(sigm_f(v1[2]), sigm_f(v1[3]));
                    *(u32x4*)(rowp + bj * HALF) = w; } }
    }
};
template <bool ADD, int MF> struct EpiGateMulF { static constexpr bool PERM = true, AFTER_DRAIN = false; const bf16_t* G; const bf16_t* P; bf16_t* O;
    __device__ __forceinline__ void operator()(const f32x4 (&acc)[2][2][MF][2], const Unit& u, int wr, int wc, int fr, int fq) const {
        const int row0 = u.pm * (64 * MF) + wr * (16 * MF) + fr, col0 = u.pn * BM + wc * 32 + 8 * fq;
#pragma unroll
        for (int ai = 0; ai < 2; ++ai)
#pragma unroll
            for (int m = 0; m < MF; ++m) { const size_t ro = (size_t)(row0 + ai * (32 * MF) + m * 16) * DM + col0;
#pragma unroll
                for (int bj = 0; bj < 2; ++bj) { const f32x4 v0 = acc[ai][bj][m][0], v1 = acc[ai][bj][m][1];
                    const u32x4 g = *(const u32x4*)(G + ro + bj * HALF);
                    float r[8] = {bflo(g.x) * v0[0], bfhi(g.x) * v0[1], bflo(g.y) * v0[2], bfhi(g.y) * v0[3], bflo(g.z) * v1[0], bfhi(g.z) * v1[1], bflo(g.w) * v1[2], bfhi(g.w) * v1[3]};
                    if (ADD) { const u32x4 p = *(const u32x4*)(P + ro + bj * HALF);
                        r[0] += bflo(p.x); r[1] += bfhi(p.x); r[2] += bflo(p.y); r[3] += bfhi(p.y); r[4] += bflo(p.z); r[5] += bfhi(p.z); r[6] += bflo(p.w); r[7] += bfhi(p.w); }
                    u32x4 w; w.x = cvt_pk_bf16(r[0], r[1]); w.y = cvt_pk_bf16(r[2], r[3]); w.z = cvt_pk_bf16(r[4], r[5]); w.w = cvt_pk_bf16(r[6], r[7]);
                    *(u32x4*)(O + ro + bj * HALF) = w; } }
    }
};
}

#include <hip/hip_bf16.h>
#include <cmath>
namespace attn_body {
using bf16=__hip_bfloat16;
using bf16x8=__attribute__((ext_vector_type(8)))short;
using s16x4=__attribute__((ext_vector_type(4)))short;
using f32x16=__attribute__((ext_vector_type(16)))float;
using u32x4=__attribute__((ext_vector_type(4)))unsigned;
constexpr int D=64,DM=1024,KVP=256;
constexpr int NW=8,QBLK=32,QB=QBLK*NW,KVBLK=64;
__device__ __forceinline__ int crow(int r,int hi){return (r&3)+8*(r>>2)+4*hi;}
#define SBAR() __builtin_amdgcn_sched_barrier(0)
__device__ __forceinline__ void wmask(f32x16&p0,f32x16&p1,int j,int kpos0,int qpos,int hi){
  const float NEG=-INFINITY; const int kb=kpos0+64*j+4*hi;
  #pragma unroll
  for(int r=0;r<16;++r){const int kp=kb+(r&3)+8*(r>>2),d0=kp-qpos,kq=kp+32,d1=kq-qpos;
    if(d0<-128||d0>128||kp<0||kp>=4096)p0[r]=NEG; if(d1<-128||d1>128||kq<0||kq>=4096)p1[r]=NEG;}
}

constexpr int NSLOT=3, SLOTB=8192;
constexpr int LDS_K=0, LDS_V=NSLOT*SLOTB, LDS_WS=2*NSLOT*SLOTB, LDS_OST=LDS_WS+NW*64*4, LDS_BYTES=LDS_OST+NW*4096;
constexpr float C2=0.125f*1.4426950408889634f;
__device__ __forceinline__ void glds16(const void*gsrc,unsigned lds_dst){unsigned keep;
  asm volatile("s_mov_b32 %0, m0\n\ts_mov_b32 m0, %2\n\ts_nop 0\n\tglobal_load_lds_dwordx4 %1, off\n\ts_mov_b32 m0, %0":"=&s"(keep):"v"(gsrc),"s"(lds_dst):"memory");}
__device__ __forceinline__ float max3f(float a,float b,float c){float r;asm("v_max3_f32 %0, %1, %2, %3":"=v"(r):"v"(a),"v"(b),"v"(c));return r;}
__device__ __forceinline__ float max2f(float a,float b){float r;asm("v_max_f32_e32 %0, %1, %2":"=v"(r):"v"(a),"v"(b));return r;}
__device__ __forceinline__ float fadd_s(float a,float b){float r;asm("v_add_f32_e32 %0, %1, %2":"=v"(r):"v"(a),"v"(b));return r;}
__device__ __forceinline__ float fsub_s(float a,float b){float r;asm("v_sub_f32_e32 %0, %1, %2":"=v"(r):"v"(a),"v"(b));return r;}
typedef float f32x2_t __attribute__((ext_vector_type(2))); typedef __bf16 bf16x2_t __attribute__((ext_vector_type(2)));
__device__ __forceinline__ unsigned cvtpk_s(float lo,float hi){f32x2_t v={lo,hi};bf16x2_t b=__builtin_convertvector(v,bf16x2_t);return __builtin_bit_cast(unsigned,b);}
#define WAIT_BAR(N) asm volatile("s_waitcnt vmcnt(" #N ") lgkmcnt(0)\n\ts_barrier":::"memory")

__device__ __forceinline__ void qkt(f32x16&p0,f32x16&p1,const char*Kslot,const bf16x8*qr,const f32x16&negm,int r32,int hi){
  const char*kb=Kslot+hi*1024+r32*16;
  #pragma unroll
  for(int d0=0;d0<4;++d0){
    const bf16x8 b0=*reinterpret_cast<const bf16x8*>(kb+d0*2048);
    const bf16x8 b1=*reinterpret_cast<const bf16x8*>(kb+d0*2048+512);
    if(d0==0){p0=__builtin_amdgcn_mfma_f32_32x32x16_bf16(b0,qr[0],negm,0,0,0);p1=__builtin_amdgcn_mfma_f32_32x32x16_bf16(b1,qr[0],negm,0,0,0);}
    else{p0=__builtin_amdgcn_mfma_f32_32x32x16_bf16(b0,qr[d0],p0,0,0,0);p1=__builtin_amdgcn_mfma_f32_32x32x16_bf16(b1,qr[d0],p1,0,0,0);}}
}
typedef __attribute__((address_space(3))) const char* lds_cptr;
typedef short v4i16_t __attribute__((ext_vector_type(4)));
__device__ __forceinline__ void kload8(bf16x8*kf,lds_cptr kp){
  kf[0]=*(const __attribute__((address_space(3))) bf16x8*)(kp);      kf[1]=*(const __attribute__((address_space(3))) bf16x8*)(kp+512);
  kf[2]=*(const __attribute__((address_space(3))) bf16x8*)(kp+2048); kf[3]=*(const __attribute__((address_space(3))) bf16x8*)(kp+2560);
  kf[4]=*(const __attribute__((address_space(3))) bf16x8*)(kp+4096); kf[5]=*(const __attribute__((address_space(3))) bf16x8*)(kp+4608);
  kf[6]=*(const __attribute__((address_space(3))) bf16x8*)(kp+6144); kf[7]=*(const __attribute__((address_space(3))) bf16x8*)(kp+6656);
}
__device__ __forceinline__ void kload2(bf16x8*kf,lds_cptr kp,int j){ kf[2*j]=*(const __attribute__((address_space(3))) bf16x8*)(kp+j*2048); kf[2*j+1]=*(const __attribute__((address_space(3))) bf16x8*)(kp+j*2048+512); }
__device__ __forceinline__ s16x4 vtr(lds_cptr p){ return __builtin_bit_cast(s16x4,__builtin_amdgcn_ds_read_tr16_b64_v4i16((__attribute__((address_space(3))) v4i16_t*)p)); }
__device__ __forceinline__ float rowmax(const f32x16&p0,const f32x16&p1){
  float a=max3f(p0[0],p0[1],p1[0]),b=max3f(p0[2],p0[3],p1[1]);a=max3f(a,p1[2],p1[3]);
  #pragma unroll
  for(int r=4;r<16;r+=4){a=max3f(a,p0[r],p0[r+1]);b=max3f(b,p0[r+2],p0[r+3]);a=max3f(a,p1[r],p1[r+1]);b=max3f(b,p1[r+2],p1[r+3]);}
  const float m=max2f(a,b);
  auto rr=__builtin_amdgcn_permlane32_swap(__float_as_uint(m),__float_as_uint(m),false,false);
  return max2f(__uint_as_float(rr[0]),__uint_as_float(rr[1]));
}
__device__ __forceinline__ void pv(f32x16*o,int vb,bf16x8 pa0,bf16x8 pa1,bf16x8 pa2,bf16x8 pa3){
  #pragma unroll
  for(int d0=0;d0<2;++d0){s16x4 lo[4],hi[4];
    #pragma unroll
    for(int ks=0;ks<4;++ks){
      asm volatile("ds_read_b64_tr_b16 %0,%1 offset:%c2":"=&v"(lo[ks]):"v"(vb),"i"(d0*4096+ks*1024):"memory");
      asm volatile("ds_read_b64_tr_b16 %0,%1 offset:%c2":"=&v"(hi[ks]):"v"(vb),"i"(d0*4096+ks*1024+512):"memory");}
    asm volatile("s_waitcnt lgkmcnt(0)":::"memory");SBAR();
    #define PK(k) (bf16x8){lo[k][0],lo[k][1],lo[k][2],lo[k][3],hi[k][0],hi[k][1],hi[k][2],hi[k][3]}
    o[d0]=__builtin_amdgcn_mfma_f32_32x32x16_bf16(pa0,PK(0),o[d0],0,0,0);
    o[d0]=__builtin_amdgcn_mfma_f32_32x32x16_bf16(pa1,PK(1),o[d0],0,0,0);
    o[d0]=__builtin_amdgcn_mfma_f32_32x32x16_bf16(pa2,PK(2),o[d0],0,0,0);
    o[d0]=__builtin_amdgcn_mfma_f32_32x32x16_bf16(pa3,PK(3),o[d0],0,0,0);
    #undef PK
  }
}

#ifndef ATTN_STORE16
#define ATTN_STORE16(p,v) (*(u32x4*)(p)=(v))
#endif
template<int THRL> __device__ __forceinline__ void attn_unit(long qrow0,int kvh,const bf16*__restrict__ Kb,const bf16*__restrict__ Vb,int NT,int woff,bool lat,int qpos0,const float*sinkp,const bf16*Q,bf16*O,char*shm,bool dry=false){
  const int tid=threadIdx.x,lane=tid&63,r32=lane&31,hi=lane>>5; const int wid=__builtin_amdgcn_readfirstlane(tid>>6);
  const int h=4*kvh+(wid&3), rowoff=(wid>>2)*QBLK;
  const float sinkl2=sinkp[h]*1.4426950408889634f;
  const bf16*Qw=Q+(qrow0+rowoff)*DM+h*D;
  const bf16*Kh=Kb+kvh*D,*Vh=Vb+kvh*D;
  const unsigned lds0=(unsigned)(uintptr_t)shm;
  float*wsf=(float*)(shm+LDS_WS)+wid*64;
  const bf16*ksrc=Kh+(long)lane*KVP+wid*8;
  const bf16*vsrc=Vh+(long)(16*(wid&3)+(lane>>2))*KVP+(wid>>2)*32+(lane&3)*8;
  const unsigned kdst=lds0+LDS_K+wid*1024, vdst=lds0+LDS_V+wid*1024;
  #define TROW(t) ((long)(t)*KVBLK+(((t)>=8)?woff:0))
  #define DMA_K(t,slot) glds16(ksrc+TROW(t)*KVP,(unsigned)__builtin_amdgcn_readfirstlane(kdst+(slot)))
  #define DMA_V(t,slot) glds16(vsrc+TROW(t)*KVP,(unsigned)__builtin_amdgcn_readfirstlane(vdst+(slot)))
  const int vb0=(int)(lds0+LDS_V)+((lane>>4)&1)*32+(lane&3)*8+(4*hi+((lane&15)>>2))*64;
  const char*Kbase=shm+LDS_K; bf16x8 kf[8];
  const lds_cptr shm3=(lds_cptr)shm; const lds_cptr kp0=shm3+LDS_K+hi*1024+r32*16; const lds_cptr vp0=shm3+LDS_V+((lane>>4)&1)*32+(lane&3)*8+(4*hi+((lane&15)>>2))*64;
  DMA_K(0,0);DMA_V(0,0);DMA_K(1,SLOTB);
  bf16x8 qr[4];
  #pragma unroll
  for(int d0=0;d0<4;++d0)qr[d0]=*reinterpret_cast<const bf16x8*>(&Qw[(long)r32*DM+d0*16+hi*8]);
  float mhat=0.f,l_reg=0.f;f32x16 o[2];o[0]=f32x16{};o[1]=f32x16{};f32x16 negm=f32x16{};asm volatile("":"+v"(negm));
  const int qpos=qpos0+rowoff+r32;
  #define CMASK(P0,P1,t) do{ if(lat&&(t)>=8)wmask(P0,P1,(t)-8,qpos0-128,qpos,hi); }while(0)
  bool resc=false;
  #define START(P0,P1) do{ const float rm=rowmax(P0,P1); resc=false; \
    { const float dl=rm; mhat=fadd_s(mhat,dl); \
      _Pragma("unroll") for(int r=0;r<16;++r){P0[r]=fsub_s(P0[r],dl);P1[r]=fsub_s(P1[r],dl);} \
      _Pragma("unroll") for(int r=0;r<16;++r)negm[r]=-mhat; asm volatile("":"+v"(negm)); } \
    _Pragma("unroll") for(int r=0;r<16;++r)P0[r]=__builtin_amdgcn_exp2f(P0[r]); }while(0)
  #define RESC() do{ if(resc){ asm volatile("s_waitcnt lgkmcnt(0)":::"memory"); \
      _Pragma("unroll") for(int d_=0;d_<2;++d_) _Pragma("unroll") for(int r=0;r<16;++r)o[d_][r]*=wsf[crow(r,hi)]; } }while(0)
  f32x16 pA0,pA1,pB0,pB1;
  int sl_prev=0,sl_cur=0,sl_next=SLOTB;
  #define ROT() do{sl_prev=sl_cur;sl_cur=sl_next;sl_next=(sl_next==(NSLOT-1)*SLOTB)?0:sl_next+SLOTB;}while(0)
  DMA_K(2,2*SLOTB);
  WAIT_BAR(3);
  qkt(pA0,pA1,Kbase,qr,negm,r32,hi);asm volatile("s_nop 15\n\ts_nop 7":"+v"(pA0),"+v"(pA1));CMASK(pA0,pA1,0);
  START(pA0,pA1);
  _Pragma("unroll") for(int r=0;r<16;++r)pA1[r]=__builtin_amdgcn_exp2f(pA1[r]);
  WAIT_BAR(0);
  DMA_K(3,0);DMA_V(1,SLOTB);
  ROT();
  kload8(kf,kp0+sl_cur);
  WAIT_BAR(2);
  s16x4 vlo[8],vhi[8]; u32x4 pw0,pw1,pw2,pw3;
  #define PKW(P,B) cvtpk_s(P[B],P[B+1])
  #define PAF(k) __builtin_bit_cast(bf16x8,pw##k)
  #define VFR(i) (bf16x8){vlo[i][0],vlo[i][1],vlo[i][2],vlo[i][3],vhi[i][0],vhi[i][1],vhi[i][2],vhi[i][3]}
  #define PIN(x) asm volatile("":"+v"(x))
  #define MX3(a,b,c) __builtin_fmaxf(__builtin_fmaxf((a),(b)),(c))
  #define GAPA(MF,A0,A1,A2,A3,W0,W1,PW) do{ MF; sacc+=A0; sacc+=A1; sacc+=A2; sacc+=A3; PIN(sacc); W0; W1; PIN(PW); SBAR(); }while(0)
  #define EX(v) __builtin_amdgcn_exp2f(v)
  #define GAPB(MF,X,B) do{ MF; X[B]=EX(X[B]); X[B+1]=EX(X[B+1]); X[B+2]=EX(X[B+2]); X[B+3]=EX(X[B+3]); PIN(X); SBAR(); }while(0)
  #define VRD(i) do{ vlo[i]=vtr(vp_+(((i)>>2)*4096+((i)&3)*1024)); vhi[i]=vtr(vp_+(((i)>>2)*4096+((i)&3)*1024+512)); }while(0)
  #define KRD(G,j) do{ if(G){ kload2(kf,kp0+sl_next,j); SBAR(); } }while(0)
  #define STEP(C0,C1,P0,P1,t,GK,GV,GL) do{ SBAR(); \
    const lds_cptr vp_=vp0+sl_prev; \
    VRD(0); SBAR(); float sacc=(P0[0]+P0[1]); \
    GAPA(C0=__builtin_amdgcn_mfma_f32_32x32x16_bf16(kf[0],qr[0],negm,0,0,0), P0[2],P0[3],P0[4],P0[5],     pw0[0]=PKW(P0,0), pw0[1]=PKW(P0,2), pw0); \
    VRD(4); SBAR(); GAPA(C1=__builtin_amdgcn_mfma_f32_32x32x16_bf16(kf[1],qr[0],negm,0,0,0), P0[6],P0[7],P0[8],P0[9],     pw0[2]=PKW(P0,4), pw0[3]=PKW(P0,6), pw0); \
    VRD(1); SBAR(); GAPA(C0=__builtin_amdgcn_mfma_f32_32x32x16_bf16(kf[2],qr[1],C0,0,0,0),   P0[10],P0[11],P0[12],P0[13], pw1[0]=PKW(P0,8), pw1[1]=PKW(P0,10), pw1); \
    VRD(5); SBAR(); GAPA(C1=__builtin_amdgcn_mfma_f32_32x32x16_bf16(kf[3],qr[1],C1,0,0,0),   P0[14],P0[15],P1[0],P1[1],   pw1[2]=PKW(P0,12),pw1[3]=PKW(P0,14), pw1); \
    VRD(2); SBAR(); GAPA(C0=__builtin_amdgcn_mfma_f32_32x32x16_bf16(kf[4],qr[2],C0,0,0,0),   P1[2],P1[3],P1[4],P1[5],     pw2[0]=PKW(P1,0), pw2[1]=PKW(P1,2), pw2); \
    VRD(6); SBAR(); GAPA(C1=__builtin_amdgcn_mfma_f32_32x32x16_bf16(kf[5],qr[2],C1,0,0,0),   P1[6],P1[7],P1[8],P1[9],     pw2[2]=PKW(P1,4), pw2[3]=PKW(P1,6), pw2); \
    VRD(3); SBAR(); GAPA(C0=__builtin_amdgcn_mfma_f32_32x32x16_bf16(kf[6],qr[3],C0,0,0,0),   P1[10],P1[11],P1[12],P1[13], pw3[0]=PKW(P1,8), pw3[1]=PKW(P1,10), pw3); \
    VRD(7); SBAR(); GAPA(C1=__builtin_amdgcn_mfma_f32_32x32x16_bf16(kf[7],qr[3],C1,0,0,0),   P1[14],P1[15],0.f,0.f,       pw3[2]=PKW(P1,12),pw3[3]=PKW(P1,14), pw3); \
    l_reg+=sacc; \
    if(GK){DMA_K((t)+3,sl_cur);} if(GV){DMA_V((t)+1,sl_next);} \
    CMASK(C0,C1,t); \
    { float a=MX3(C0[0],C0[1],C1[0]),b=MX3(C0[2],C0[3],C1[1]); a=MX3(a,C1[2],C1[3]); \
      _Pragma("unroll") for(int r=4;r<16;r+=4){a=MX3(a,C0[r],C0[r+1]);b=MX3(b,C0[r+2],C0[r+3]);a=MX3(a,C1[r],C1[r+1]);b=MX3(b,C1[r+2],C1[r+3]);} \
      float rm=__builtin_fmaxf(a,b); { auto rr=__builtin_amdgcn_permlane32_swap(__float_as_uint(rm),__float_as_uint(rm),false,false); rm=__builtin_fmaxf(__uint_as_float(rr[0]),__uint_as_float(rr[1])); } \
      resc=false; \
      if(__builtin_expect(__any(rm>(float)THRL),0)){ const float dl=__builtin_fmaxf(rm,0.f); mhat+=dl; \
        _Pragma("unroll") for(int r=0;r<16;++r){C0[r]-=dl;C1[r]-=dl;} \
        _Pragma("unroll") for(int r=0;r<16;++r)negm[r]=-mhat; asm volatile("":"+v"(negm)); \
        const float f=__builtin_amdgcn_exp2f(-dl); l_reg*=f; if(hi==0)wsf[r32]=f; resc=true; } } \
    SBAR(); \
    GAPB(o[0]=__builtin_amdgcn_mfma_f32_32x32x16_bf16(PAF(0),VFR(0),o[0],0,0,0), C0,0); \
    GAPB(o[1]=__builtin_amdgcn_mfma_f32_32x32x16_bf16(PAF(0),VFR(4),o[1],0,0,0), C0,4); \
    KRD(GL,0); GAPB(o[0]=__builtin_amdgcn_mfma_f32_32x32x16_bf16(PAF(1),VFR(1),o[0],0,0,0), C0,8); \
    KRD(GL,1); GAPB(o[1]=__builtin_amdgcn_mfma_f32_32x32x16_bf16(PAF(1),VFR(5),o[1],0,0,0), C0,12); \
    KRD(GL,2); GAPB(o[0]=__builtin_amdgcn_mfma_f32_32x32x16_bf16(PAF(2),VFR(2),o[0],0,0,0), C1,0); \
    KRD(GL,3); GAPB(o[1]=__builtin_amdgcn_mfma_f32_32x32x16_bf16(PAF(2),VFR(6),o[1],0,0,0), C1,4); \
    GAPB(o[0]=__builtin_amdgcn_mfma_f32_32x32x16_bf16(PAF(3),VFR(3),o[0],0,0,0), C1,8); \
    GAPB(o[1]=__builtin_amdgcn_mfma_f32_32x32x16_bf16(PAF(3),VFR(7),o[1],0,0,0), C1,12); \
    }while(0)
  int t=1;
  #undef CMASK
  #define CMASK(P0,P1,t) do{}while(0)
  for(;t+5<NT&&t+1<8;t+=2){
    STEP(pB0,pB1,pA0,pA1,t,true,true,true);     WAIT_BAR(2); RESC(); ROT();
    STEP(pA0,pA1,pB0,pB1,t+1,true,true,true);   WAIT_BAR(2); RESC(); ROT();
  }
  #undef CMASK
  #define CMASK(P0,P1,t) do{ if(lat&&(t)>=8)wmask(P0,P1,(t)-8,qpos0-128,qpos,hi); }while(0)
  #define ENDW(tt) do{ if((tt)+3<NT){WAIT_BAR(2);} else if((tt)+2<NT){WAIT_BAR(1);} else {WAIT_BAR(0);} }while(0)
  for(;t+2<NT;t+=2){
    STEP(pB0,pB1,pA0,pA1,t,(t+3<NT),(t+1<NT),(t+1<NT));       ENDW(t);   RESC(); ROT();
    STEP(pA0,pA1,pB0,pB1,t+1,(t+4<NT),(t+2<NT),(t+2<NT));     ENDW(t+1); RESC(); ROT();
  }
  #define DRAIN(P0,P1) do{ float sacc=P0[0]+P0[1]; _Pragma("unroll") for(int r=2;r<16;++r)sacc+=P0[r]; _Pragma("unroll") for(int r=0;r<16;++r)sacc+=P1[r]; l_reg+=sacc; \
    pw0=(u32x4){PKW(P0,0),PKW(P0,2),PKW(P0,4),PKW(P0,6)};pw1=(u32x4){PKW(P0,8),PKW(P0,10),PKW(P0,12),PKW(P0,14)};pw2=(u32x4){PKW(P1,0),PKW(P1,2),PKW(P1,4),PKW(P1,6)};pw3=(u32x4){PKW(P1,8),PKW(P1,10),PKW(P1,12),PKW(P1,14)}; \
    SBAR(); pv(o,vb0+sl_cur,PAF(0),PAF(1),PAF(2),PAF(3)); }while(0)
  if(NT&1){
    STEP(pB0,pB1,pA0,pA1,t,(t+3<NT),(t+1<NT),(t+1<NT));       ENDW(t);   RESC(); ROT();
    STEP(pA0,pA1,pB0,pB1,NT-1,false,false,false); RESC();
    DRAIN(pA0,pA1);
  }else{
    STEP(pB0,pB1,pA0,pA1,NT-1,false,false,false); RESC();
    DRAIN(pB0,pB1);
  }
  #undef DRAIN
  #undef PKW
  #undef PAF
  #undef VFR
  #undef PIN
  #undef MX3
  #undef GAPA
  #undef GAPB
  #undef EX
  #undef VRD
  #undef KRD
  #undef STEP
  #undef ENDW
  {auto rr=__builtin_amdgcn_permlane32_swap(__float_as_uint(l_reg),__float_as_uint(l_reg),false,false);l_reg=__uint_as_float(rr[0])+__uint_as_float(rr[1]);}
  l_reg+=__builtin_amdgcn_exp2f(sinkl2-mhat);
  if(hi==0)wsf[32+r32]=l_reg;asm volatile("s_waitcnt lgkmcnt(0)":::"memory");
  float rli[16];
  #pragma unroll
  for(int r=0;r<16;++r)rli[r]=__builtin_amdgcn_rcpf(wsf[32+crow(r,hi)]);
  bf16*Ow=O+(qrow0+rowoff)*DM+h*D;
  { bf16*stg=(bf16*)(shm+LDS_OST)+wid*2048;
    #pragma unroll
    for(int r=0;r<16;++r){const int orow=crow(r,hi);
      #pragma unroll
      for(int d0=0;d0<2;++d0)stg[orow*64+d0*32+r32]=__float2bfloat16(o[d0][r]*rli[r]);}
    asm volatile("s_waitcnt lgkmcnt(0)":::"memory");
    #pragma unroll
    for(int i=0;i<4;++i){const int row=i*8+(lane>>3),ch=lane&7; const u32x4 v=*(const u32x4*)(stg+row*64+ch*8); if(!dry)ATTN_STORE16(Ow+(long)row*DM+ch*8,v);} }
  asm volatile("s_waitcnt lgkmcnt(0)\n\ts_barrier":::"memory");
  #undef TROW
  #undef DMA_K
  #undef DMA_V
  #undef CMASK
  #undef START
  #undef RESC
  #undef ROT
}
#undef SBAR
#undef WAIT_BAR
}

__device__ __forceinline__ void attn_fast(const Args& args, Frame& F, unsigned char* ldsg, bool dry = false) {
    typedef attn_body::bf16 abf;
    const abf* Q = (const abf*)WSP(bf16, WS_Q);
    for (int i = F.bid; i < 2048 + 256; i += F.G) {
        if (i < 2048) { const int qb = i & 63, kvh = (i >> 6) & 3, bl = i >> 8;
            attn_body::attn_unit<8>((long)NCTX + (long)bl * LSEQ + qb * 64, kvh, (const abf*)(WSP(bf16, WS_KL) + (size_t)bl * KLROWS * KVW), (const abf*)(WSP(bf16, WS_VL) + (size_t)bl * KLROWS * KVW),
                                    13, 64 * qb - 128, true, 64 * qb, args.in[I_SINK], Q, (abf*)Q, (char*)ldsg, dry); }
        else { const int j = i - 2048, qb = j & 3, kvh = (j >> 2) & 3, bc = j >> 4;
            attn_body::attn_unit<8>((long)bc * CSEQ + qb * 64, kvh, (const abf*)(WSP(bf16, WS_KC) + (size_t)bc * CSEQ * KVW), (const abf*)(WSP(bf16, WS_VC) + (size_t)bc * CSEQ * KVW),
                                    4, 0, false, 0, args.in[I_SINK], Q, (abf*)Q, (char*)ldsg, dry); }
    }
}

#define XB_TMO      128
#define XB_XCNT(j)  (256  + 64 * (j))
#define XB_XSUB(j)  (1280 + 64 * (j))
#define XB_XGEN(j)  (2304 + 64 * (j))
#define XB_TOP      3328
#define XB_TOPGEN   3392
#define XCD_BAR_WORDS 3456
#define XB_SPIN_CAP (1u << 24)
__device__ __forceinline__ unsigned xb_ld(unsigned* p)              { return __hip_atomic_load(p, __ATOMIC_RELAXED, __HIP_MEMORY_SCOPE_AGENT); }
__device__ __forceinline__ unsigned xb_add(unsigned* p, unsigned v) { return __hip_atomic_fetch_add(p, v, __ATOMIC_RELAXED, __HIP_MEMORY_SCOPE_AGENT); }
__device__ __forceinline__ unsigned xb_xcc_id() { return (unsigned)__builtin_amdgcn_s_getreg((3 << 11) | 20) & 0xFu; }
#define XB_SPIN(cond, bar) do { unsigned _sp = 0; while (cond) { __builtin_amdgcn_s_sleep(1); \
    if ((++_sp & 255u) == 0u) { if (xb_ld(&(bar)[XB_TMO])) break; if (_sp > XB_SPIN_CAP) { atomicAdd(&(bar)[XB_TMO], 1u); break; } } } } while (0)
struct XcdBarrier { unsigned* bar; unsigned x; volatile LAS unsigned* st; };
__device__ __forceinline__ XcdBarrier xcd_barrier_post(unsigned* bar, volatile LAS unsigned* st) {
    XcdBarrier b; b.bar = bar; b.x = xb_xcc_id(); b.st = st;
    if (threadIdx.x == 0) (void)xb_add(&bar[XB_XCNT(b.x)], 1u);
    return b;
}
__device__ __forceinline__ void xcd_barrier_complete(unsigned* bar, unsigned x, unsigned& nloc, unsigned& nx) {
    const unsigned G = gridDim.x * gridDim.y * gridDim.z;
    unsigned sum, cnt, mine, sp = 0u;
    for (;;) {
        sum = 0u; cnt = 0u; mine = 0u;
#pragma unroll
        for (unsigned j = 0; j < 16; ++j) { const unsigned c = xb_ld(&bar[XB_XCNT(j)]); sum += c; cnt += (c > 0u) ? 1u : 0u; mine = (j == x) ? c : mine; }
        if (sum == G) break;
        __builtin_amdgcn_s_sleep(1);
        if ((++sp & 255u) == 0u) { if (xb_ld(&bar[XB_TMO])) break; if (sp > XB_SPIN_CAP) { atomicAdd(&bar[XB_TMO], 1u); break; } }
    }
    nloc = mine > 0u ? mine : 1u; nx = cnt > 0u ? cnt : 1u;
}
__device__ __forceinline__ void xcd_barrier(const XcdBarrier& b) {
    asm volatile("s_waitcnt vmcnt(0)" ::: "memory");
    __syncthreads();
    if (threadIdx.x == 0) {
        unsigned* bar = b.bar;
        __builtin_amdgcn_s_waitcnt(0);
        unsigned nloc = b.st[0], nx = b.st[1];
        if (nloc == 0u) { xcd_barrier_complete(bar, b.x, nloc, nx); b.st[0] = nloc; b.st[1] = nx; }
        const unsigned bk_ = b.st[2];
        const unsigned old = xb_add(&bar[XB_XSUB(b.x)], 1u);
        const unsigned gen = old / nloc;
        if (old + 1u == (gen + 1u) * nloc) {
            __builtin_amdgcn_fence(__ATOMIC_RELEASE, "agent");
            asm volatile("s_waitcnt vmcnt(0)" ::: "memory");
            (void)xb_add(&bar[XB_TOP], 1u);
            { const unsigned target = (b.st[2] + 1u) * nx; XB_SPIN(xb_ld(&bar[XB_TOP]) < target, bar); }
            xb_add(&bar[XB_XGEN(b.x)], 1u);
            __builtin_amdgcn_fence(__ATOMIC_ACQUIRE, "agent");
            asm volatile("s_waitcnt vmcnt(0)" ::: "memory");
        } else {
            XB_SPIN(xb_ld(&bar[XB_XGEN(b.x)]) == gen, bar);
            __builtin_amdgcn_fence(__ATOMIC_ACQUIRE, "agent");
            asm volatile("s_waitcnt vmcnt(0)" ::: "memory");
        }
        b.st[2] = bk_ + 1u;
    }
    __syncthreads();
}

constexpr int NPHASE = 15;
constexpr int CW_BAR = 4096;
__global__ void __launch_bounds__(NTHR, 2) mega(Args args) {
    extern __shared__ __attribute__((aligned(16))) unsigned char lds[];
    Frame F;
    F.lds = (LAS unsigned char*)lds; F.tid = threadIdx.x; F.lane = F.tid & 63; F.wave = __builtin_amdgcn_readfirstlane(F.tid >> 6);
    F.G = gridDim.x; F.bid = blockIdx.x; F.out = args.out; F.ws = args.ws;
    volatile LAS unsigned* MISC = (volatile LAS unsigned*)(F.lds + LDS_BYTES - 64);
    if (F.tid < 16) MISC[F.tid] = 0u;
    __syncthreads();
    XcdBarrier bar; bar.bar = (unsigned*)(F.ws + WS_CTL) + CW_BAR; bar.x = 0; bar.st = nullptr;
    if (MK_ONE_LAUNCH) bar = xcd_barrier_post((unsigned*)(F.ws + WS_CTL) + CW_BAR, MISC + 8);
    const int lo = args.ph_lo, hi = args.ph_hi;
#define IN(k) (lo <= (k) && (k) < hi)
#define REP(k) for (int rep_ = 0; rep_ < 1 + (((REPMASK) >> (k)) & 1); ++rep_)
#define SEAM(k) do { if (IN(k) && IN((k) + 1)) xcd_barrier(bar); } while (0)
    const float* MOD = WSP(float, WS_MOD);
    typedef pg8::EpiResB3<0, false> EpiRes3In; typedef pg8::EpiResB3<1, false> EpiRes3Mid; typedef pg8::EpiResB3<1, true> EpiRes3Out;
    bf16* GA_ = (bf16*)F.out + (size_t)MTOK * DM;
    bf16* X1 = (bf16*)F.out; bf16* X2 = WSP(bf16, WS_A);
 typedef pg8::EpiGateMulF<false, 3> EpiMul; typedef pg8::EpiGateMulF<true, 3> EpiMulAdd;
#define GEMM_PHASE(EPI_T, Aptr, Bptr, M_, N_, K_, ...) do { pg8::Gemm g_{Aptr, Bptr, M_, N_, K_}; pg8::StaticOrder S_; S_.init(M_, N_, F.G, F.bid); \
        EPI_T E_{__VA_ARGS__}; pg8::gemm_phase<EPI_T, pg8::StaticOrder, true, true>(F.lds, g_, S_, E_); } while (0)
    if (IN(0)) REP(0) { p0_mod(args, F); __syncthreads(); p0_weights(args, F); p0_h2(args, F);
        for (int i = F.bid * NTHR + F.tid; i < 1024; i += F.G * NTHR) { const float ang = (float)(i >> 4) * powf(10000.0f, -(float)(i & 15) / 16.0f); WSP(float, WS_ROPE)[2 * i] = cosf(ang); WSP(float, WS_ROPE)[2 * i + 1] = sinf(ang); } } SEAM(0);
    if (IN(1)) REP(1) { norm_rows(args, F, 0, WSP(bf16, WS_A)); p1_taps(args, F); } SEAM(1);
#define GEMM_PHASE3(EPI_T, Aptr, Bptr, M_, N_, K_, ...) do { pg8::Gemm g_{Aptr, Bptr, M_, N_, K_}; pg8::StaticOrder S_; S_.init(M_, N_, F.G, F.bid, 192); \
        EPI_T E_{__VA_ARGS__}; pg8::gemm_phase<EPI_T, pg8::StaticOrder, true, true, 3>(F.lds, g_, S_, E_); } while (0)
#define FG(k) (((FASTMASK) >> (k)) & 1)
    if (IN(2)) REP(2) { if (FG(2)) GEMM_PHASE(pg8::EpiSwigluF, WSP(bf16, WS_A), WSP(bf16, WS_WI1), MTOK, 2 * DFF, DM, WSP(bf16, WS_U));
                 else sgemm<2>(args, F, WSP(bf16, WS_A), WSP(bf16, WS_WI1), MTOK, DFF, DM, RmGate{}, RmUp{}, EpiSwiglu{WSP(bf16, WS_U)}); } SEAM(2);
    if (IN(3)) REP(3) { GEMM_PHASE3(EpiRes3In, WSP(bf16, WS_U), WSP(bf16, WS_WO1), MTOK, DM, DFF, args.in[I_XP], args.in[I_XS], nullptr, X1, nullptr, MOD, 2 * DM, 0.5f); } SEAM(3);
    if (IN(4)) REP(4) { norm_rows_b(args, F, 1, X1, WSP(bf16, WS_A)); cache_rows(args, F); } SEAM(4);
    if (IN(5)) REP(5) { if (FG(5)) GEMM_PHASE(pg8::EpiQKVF, WSP(bf16, WS_A), WSP(bf16, WS_WQKV), MTOK, NQKV, DM, WSP(bf16, WS_Q), WSP(bf16, WS_KC), WSP(bf16, WS_KL), WSP(bf16, WS_VC), WSP(bf16, WS_VL),
                            F.out + OUT_NK, F.out + OUT_NV, args.in[I_QN], args.in[I_KN], WSP(float, WS_ROPE));
                 else qkv_naive(args, F);
                 if (FG(6)) GEMM_PHASE(pg8::EpiBf16P, WSP(bf16, WS_WHY), WSP(bf16, WS_A), NHY, MTOK, DM, WSP(bf16, WS_HYT), MTOK);
                 else sgemm<1>(args, F, WSP(bf16, WS_WHY), WSP(bf16, WS_A), NHY, MTOK, DM, RmId{}, RmId{}, EpiHyT{WSP(bf16, WS_HYT)}); } SEAM(5);
    if (IN(6)) {
#if FAST_ATTN
        if (DRY_AT) { attn_fast(args, F, lds, args.pad == 0); __syncthreads(); }
        attn_fast(args, F, lds); __syncthreads();
#else
        attn_naive(args, F);
#endif
#if FAST_HYENA
#if HY_FFT
        if (DRY_HY) { hyena_fft(args, F, args.pad == 0); __syncthreads(); hyena_fast<false>(args, F, args.pad == 0); }
#else
        if (DRY_HY) { hyena_fast<true>(args, F, args.pad == 0); hyena_fast<false>(args, F, args.pad == 0); }
#endif
#if HY_FFT
        hyena_fft(args, F); __syncthreads(); hyena_fast<false>(args, F);
#else
        hyena_fast<true>(args, F); hyena_fast<false>(args, F);
#endif
#else
        hyena_naive(args, F);
#endif
    } SEAM(6);
    if (IN(7)) REP(7) { hy_transpose(args, F); __syncthreads(); }
    if (IN(8)) REP(8) { if (FG(8)) GEMM_PHASE(pg8::EpiGatesF, WSP(bf16, WS_A), WSP(bf16, WS_WG), MTOK, NGATE, DM, GA_, WSP(bf16, WS_GH));
                 else sgemm<1>(args, F, WSP(bf16, WS_A), WSP(bf16, WS_WG), MTOK, NGATE, DM, RmId{}, RmId{}, EpiGates{GA_, WSP(bf16, WS_GH)}); } SEAM(8);
    if (IN(9)) REP(9) { if (FG(9)) GEMM_PHASE3(EpiMul, WSP(bf16, WS_Q), WSP(bf16, WS_WA), MTOK, DM, DM, GA_, nullptr, WSP(bf16, WS_MA));
                 else sgemm<1>(args, F, WSP(bf16, WS_Q), WSP(bf16, WS_WA), MTOK, DM, DM, RmId{}, RmId{}, EpiMA{GA_, WSP(bf16, WS_MA)}); }
    if (IN(10)) REP(10) { if (FG(10)) GEMM_PHASE3(EpiMulAdd, WSP(bf16, WS_HYO), WSP(bf16, WS_WH), MTOK, DM, DM, WSP(bf16, WS_GH), WSP(bf16, WS_MA), GA_);
                  else sgemm<1>(args, F, WSP(bf16, WS_HYO), WSP(bf16, WS_WH), MTOK, DM, DM, RmId{}, RmId{}, EpiMerged{WSP(bf16, WS_GH), WSP(bf16, WS_MA), GA_}); } SEAM(10);
    if (IN(11)) REP(11) { GEMM_PHASE3(EpiRes3Mid, GA_, WSP(bf16, WS_WOUT), MTOK, DM, DM, nullptr, nullptr, X1, X2, nullptr, MOD, 5 * DM, 1.0f); } SEAM(11);
    if (IN(12)) REP(12) { norm_rows_b(args, F, 2, X2, WSP(bf16, WS_A3)); } SEAM(12);
    if (IN(13)) REP(13) { if (FG(13)) GEMM_PHASE(pg8::EpiSwigluF, WSP(bf16, WS_A3), WSP(bf16, WS_WI2), MTOK, 2 * DFF, DM, WSP(bf16, WS_U));
                  else sgemm<2>(args, F, WSP(bf16, WS_A3), WSP(bf16, WS_WI2), MTOK, DFF, DM, RmGate{}, RmUp{}, EpiSwiglu{WSP(bf16, WS_U)}); } SEAM(13);
    if (IN(14)) REP(14) { GEMM_PHASE3(EpiRes3Out, WSP(bf16, WS_U), WSP(bf16, WS_WO2), MTOK, DM, DFF, nullptr, nullptr, X2, nullptr, F.out, MOD, 8 * DM, 0.5f); }
#undef IN
#undef SEAM
}

extern "C" void kernel_launch(void* const* d_in, const int* in_sizes, int n_in, void* d_out, int out_size, void* d_ws, size_t ws_size, hipStream_t stream) {
    static int grid = 0;
    if (grid == 0) {
        if (n_in != 33 || ws_size < WS_END) { fprintf(stderr, "kernel_launch: unexpected n_in %d / ws %zu\n", n_in, ws_size); grid = -1; return; }
        int dev = 0, cus = 0;
        if (hipGetDevice(&dev) != hipSuccess || hipDeviceGetAttribute(&cus, hipDeviceAttributeMultiprocessorCount, dev) != hipSuccess) { grid = -1; return; }
        if (hipFuncSetAttribute((const void*)mega, hipFuncAttributeMaxDynamicSharedMemorySize, LDS_BYTES) != hipSuccess) { fprintf(stderr, "kernel_launch: hipFuncSetAttribute failed\n"); grid = -1; return; }
        int per_cu = 0;
        if (hipOccupancyMaxActiveBlocksPerMultiprocessor(&per_cu, (const void*)mega, NTHR, LDS_BYTES) != hipSuccess || per_cu < 1) { fprintf(stderr, "kernel_launch: occupancy query reports %d workgroups per CU; nothing launched\n", per_cu); grid = -1; (void)hipGetLastError(); return; }
        (void)hipGetLastError();
        grid = cus;
    }
    if (grid < 0) return;
    (void)hipMemsetAsync((char*)d_ws + WS_CTL, 0, CTL_ZERO_BYTES, stream);
    Args a{};
    for (int i = 0; i < 33; ++i) a.in[i] = (const float*)d_in[i];
    a.out = (float*)d_out; a.ws = (unsigned char*)d_ws;
    if (MK_ONE_LAUNCH) { a.ph_lo = 0; a.ph_hi = NPHASE; a.li = 0; hipLaunchKernelGGL(mega, dim3(grid), dim3(NTHR), LDS_BYTES, stream, a); }
    else for (int p = 0; p < NPHASE; ++p) { a.ph_lo = p; a.ph_hi = p + 1; a.li = p; hipLaunchKernelGGL(mega, dim3(grid), dim3(NTHR), LDS_BYTES, stream, a); }
}
```

```cpp
#include <hip/hip_runtime.h>
#include <cstdio>
#include <cstdint>

#ifndef REPMASK
#define REPMASK 0
#endif
#ifndef DRY_AT
#define DRY_AT 0
#endif
#ifndef DRY_HY
#define DRY_HY 0
#endif
#ifndef DRY_NOCONV
#define DRY_NOCONV 0
#endif
#ifndef HY_FFT
#define HY_FFT 1
#endif
#ifndef FAST_ATTN
#define FAST_ATTN 1
#endif
#ifndef FAST_HYENA
#define FAST_HYENA 1
#endif
#ifndef FASTMASK
#define FASTMASK 0x6F6C
#endif
#ifndef MK_ONE_LAUNCH
#define MK_ONE_LAUNCH 1
#endif

#define GAS __attribute__((address_space(1)))
#define LAS __attribute__((address_space(3)))
typedef unsigned short bf16;
typedef short bf16x8 __attribute__((ext_vector_type(8)));
typedef float f32x4 __attribute__((ext_vector_type(4)));
typedef float f32x16 __attribute__((ext_vector_type(16)));
typedef unsigned u32x4 __attribute__((ext_vector_type(4)));
typedef unsigned u32x2 __attribute__((ext_vector_type(2)));

constexpr int DM = 1024, NCTX = 16 * 256, NLAT = 8 * 4096, MTOK = NCTX + NLAT, DFF = 2816, NMODV = 9, MODW = 9 * DM;
constexpr int LSEQ = 4096, CSEQ = 256, NH = 16, NKV = 4, HD = 64, KVW = NKV * HD, PAST = 512, WIN = 128;
constexpr int INCOLS = 6656, NQKV = 1536, NHY = 3072, NGATE = 2048;
constexpr int FW = 64, FEMB = 33;
constexpr float EPSF = 1e-6f;
constexpr int KLPAD = 192, KLROWS = PAST + LSEQ + KLPAD;

constexpr size_t MiB = 1u << 20;
constexpr size_t WS_CTL = 0, CTL_ZERO_BYTES = 1 * MiB;
constexpr size_t WS_MOD = 1 * MiB;
constexpr size_t WS_H2 = 2 * MiB;
constexpr size_t WS_INVS = 4 * MiB;
constexpr size_t WS_ROPE = 5 * MiB;
constexpr size_t WS_WI1 = 10 * MiB, WS_WO1 = 21 * MiB, WS_WQKV = 27 * MiB, WS_WHY = 30 * MiB, WS_WG = 36 * MiB, WS_WA = 40 * MiB, WS_WH = 42 * MiB,
                 WS_WOUT = 44 * MiB, WS_WI2 = 46 * MiB, WS_WO2 = 57 * MiB;
constexpr size_t WS_KS = WS_WI1;
constexpr size_t WS_TAPL = 63 * MiB;
constexpr size_t WS_TAPC = 95 * MiB;
constexpr size_t WS_A = 97 * MiB;
constexpr size_t WS_U = 169 * MiB;
constexpr size_t WS_Q = 169 * MiB;
constexpr size_t WS_KC = 241 * MiB, WS_KL = 243 * MiB, WS_VC = 262 * MiB, WS_VL = 264 * MiB;
constexpr size_t WS_HYT = 283 * MiB;
constexpr size_t WS_HYO = WS_HYT + 72 * MiB;
constexpr size_t WS_GH = WS_HYT + 144 * MiB;
constexpr size_t WS_MA = WS_A, WS_A3 = WS_GH;
constexpr size_t WS_END = WS_HYT + 216 * MiB;
static_assert(WS_END <= 512 * MiB, "ws map");
constexpr size_t OUT_NK = (size_t)MTOK * DM, OUT_NV = OUT_NK + (size_t)NCTX * KVW;

constexpr int NWAVES = 8, NTHR = 512;
constexpr int LDS_BYTES = 163840;

__device__ __forceinline__ unsigned f2bf(float f) { unsigned u = __builtin_bit_cast(unsigned, f); return (u + 0x7fffu + ((u >> 16) & 1u)) >> 16; }
__device__ __forceinline__ float bf2f(unsigned b) { return __builtin_bit_cast(float, b << 16); }
__device__ __forceinline__ unsigned pk2(float lo, float hi) { return f2bf(lo) | (f2bf(hi) << 16); }
__device__ __forceinline__ float sigmoidf_(float x) { return 1.0f / (1.0f + __expf(-x)); }
__device__ __forceinline__ float wave_sum(float v) {
#pragma unroll
    for (int o = 1; o < 64; o <<= 1) v += __shfl_xor(v, o);
    return v;
}
#define LDS_WAIT() asm volatile("s_waitcnt lgkmcnt(0)" ::: "memory")
#define VM_WAIT() asm volatile("s_waitcnt vmcnt(0)" ::: "memory")

__host__ __device__ __forceinline__ int map_swiglu(int n) { const int bj = n / DFF, j = n % DFF; return 256 * (j / 128) + 128 * bj + (j % 128); }
__host__ __device__ __forceinline__ int map_qkv(int n) {
    if (n < 1024) { const int h = n / 64, d = n % 64; return 256 * (h / 4) + 128 * (d / 32) + 32 * (h % 4) + (d % 32); }
    if (n < 1280) { const int h = (n - 1024) / 64, d = n % 64; return 1024 + 128 * (d / 32) + 32 * h + (d % 32); }
    return n;
}
__device__ __forceinline__ int mod_row(int m) { return m < NCTX ? 0 : 1 + ((m - NCTX) >> 12); }

struct Args { const float* in[33]; float* out; unsigned char* ws; int ph_lo, ph_hi, li, pad; };
struct Frame {
    LAS unsigned char* lds;
    int tid, lane, wave, G, bid;
    float* out; unsigned char* ws;
};
#define WSP(T, off) ((T*)(F.ws + (off)))
enum { I_XP = 0, I_XS, I_CK, I_CV, I_C, I_CCTX, I_WMOD, I_BMOD, I_NF1, I_WI1, I_WO1, I_NMIX, I_WIN, I_QN, I_KN, I_SINK, I_CW, I_CB, I_FW1, I_FB1, I_FW2, I_FB2, I_FW3, I_FB3,
       I_FFREQ, I_FDEC, I_HSKIP, I_WA, I_WH, I_WOUT, I_NF2, I_WI2, I_WO2 };

__device__ __forceinline__ void p0_mod(const Args& args, Frame& F, int u_lo, int u_hi, int cu0) {
    LAS float* sv = (LAS float*)F.lds;
    LAS float* red = sv + 9 * 1024;
    bool have = false;
    if (F.bid < cu0) return;
    for (int u = u_lo + F.bid - cu0; u < u_hi; u += F.G - cu0) {
        if (!have) {
            for (int i = F.tid; i < 9 * 1024; i += NTHR) { const float c = (i < 1024) ? args.in[I_CCTX][i] : args.in[I_C][i - 1024]; sv[i] = c / (1.0f + __expf(-c)); }
            have = true; __syncthreads();
        }
        const int nn = F.tid & 31, kp = F.tid >> 5, n = u * 32 + nn;
        float acc[9];
#pragma unroll
        for (int i = 0; i < 9; ++i) acc[i] = 0.f;
        const float* w = args.in[I_WMOD] + (size_t)(kp * 64) * MODW + n;
#pragma unroll 1
        for (int k0 = 0; k0 < 64; k0 += 16) { float wv[16];
#pragma unroll
            for (int k = 0; k < 16; ++k) wv[k] = w[(size_t)(k0 + k) * MODW];
#pragma unroll
            for (int k = 0; k < 16; ++k)
#pragma unroll
                for (int i = 0; i < 9; ++i) acc[i] += sv[i * 1024 + kp * 64 + k0 + k] * wv[k]; }
#pragma unroll
        for (int i = 0; i < 9; ++i) red[(kp * 9 + i) * 32 + nn] = acc[i];
        __syncthreads();
        for (int e = F.tid; e < 9 * 32; e += NTHR) { const int i = e / 32, n2 = e % 32; float s = args.in[I_BMOD][u * 32 + n2];
#pragma unroll
            for (int k = 0; k < 16; ++k) s += red[(k * 9 + i) * 32 + n2];
            WSP(float, WS_MOD)[i * MODW + u * 32 + n2] = s; }
        __syncthreads();
    }
}
template <int MAP> __device__ __forceinline__ void transpose_item(const float* W, int ldw, int col0, int K, int ncols, bf16* WT, LAS float* scr, int item, int lane) {
    const int nblk = ncols / 32, kb = item / nblk, nb = item % nblk, k0 = 64 * kb, n0 = 32 * nb;
    float tv[32];
#pragma unroll
    for (int i = 0; i < 32; ++i) { const int kk = 2 * i + (lane >> 5); tv[i] = W[(size_t)(k0 + kk) * ldw + col0 + n0 + (lane & 31)]; }
#pragma unroll
    for (int i = 0; i < 32; ++i) { const int kk = 2 * i + (lane >> 5); scr[kk * 33 + (lane & 31)] = tv[i]; }
    LDS_WAIT(); asm volatile("" ::: "memory");
    const int c = lane & 7;
#pragma unroll
    for (int j = 0; j < 4; ++j) { const int n = (lane >> 3) + 8 * j; const LAS float* s = scr + (8 * c) * 33 + n;
        u32x4 o; o.x = pk2(s[0 * 33], s[1 * 33]); o.y = pk2(s[2 * 33], s[3 * 33]); o.z = pk2(s[4 * 33], s[5 * 33]); o.w = pk2(s[6 * 33], s[7 * 33]);
        const int nn = n0 + n, row = MAP == 1 ? map_swiglu(nn) : MAP == 2 ? map_qkv(nn) : nn;
        *(u32x4*)(WT + (size_t)row * K + k0 + 8 * c) = o; }
    LDS_WAIT(); asm volatile("" ::: "memory");
}
__device__ __forceinline__ void p0_weights(const Args& args, Frame& F, int part, int cu0) {
    LAS float* scr = (LAS float*)(F.lds + 65536 + F.wave * 8704);
    if (F.bid < cu0) return;
    const int gw = (F.bid - cu0) * NWAVES + F.wave, NGW = (F.G - cu0) * NWAVES;
    constexpr int I_A = 16 * 176, I_B = 44 * 32, I_C3 = 16 * 48, I_D = 16 * 96, I_E = 16 * 64, I_S = 16 * 32;
    constexpr int NEARLY = I_A  , NITEMS = 2 * I_A + 2 * I_B + I_C3 + I_D + I_E + 3 * I_S;
    for (int it = gw + (part ? NEARLY : 0); it < (part ? NITEMS : NEARLY); it += NGW) {
        int r = it;
        if (r < I_A) { transpose_item<1>(args.in[I_WI1], 2 * DFF, 0, DM, 2 * DFF, WSP(bf16, WS_WI1), scr, r, F.lane); continue; } r -= I_A;
        if (r < I_B) { transpose_item<0>(args.in[I_WO1], DM, 0, DFF, DM, WSP(bf16, WS_WO1), scr, r, F.lane); continue; } r -= I_B;
        if (r < I_C3) { transpose_item<2>(args.in[I_WIN], INCOLS, 0, DM, NQKV, WSP(bf16, WS_WQKV), scr, r, F.lane); continue; } r -= I_C3;
        if (r < I_D) { transpose_item<0>(args.in[I_WIN], INCOLS, NQKV, DM, NHY, WSP(bf16, WS_WHY), scr, r, F.lane); continue; } r -= I_D;
        if (r < I_A) { transpose_item<1>(args.in[I_WI2], 2 * DFF, 0, DM, 2 * DFF, WSP(bf16, WS_WI2), scr, r, F.lane); continue; } r -= I_A;
        if (r < I_B) { transpose_item<0>(args.in[I_WO2], DM, 0, DFF, DM, WSP(bf16, WS_WO2), scr, r, F.lane); continue; } r -= I_B;
        if (r < I_E) { transpose_item<0>(args.in[I_WIN], INCOLS, NQKV + NHY, DM, NGATE, WSP(bf16, WS_WG), scr, r, F.lane); continue; } r -= I_E;
        if (r < I_S) { transpose_item<0>(args.in[I_WA], DM, 0, DM, DM, WSP(bf16, WS_WA), scr, r, F.lane); continue; } r -= I_S;
        if (r < I_S) { transpose_item<0>(args.in[I_WH], DM, 0, DM, DM, WSP(bf16, WS_WH), scr, r, F.lane); continue; } r -= I_S;
        transpose_item<0>(args.in[I_WOUT], DM, 0, DM, DM, WSP(bf16, WS_WOUT), scr, r, F.lane);
    }
}
__device__ __forceinline__ void p0_h2(const Args& args, Frame& F, int cu0) {
    if (F.bid < cu0) return;
    const int gw = (F.bid - cu0) * NWAVES + F.wave, NGW = (F.G - cu0) * NWAVES, lane = F.lane;
    const float* w1 = args.in[I_FW1]; const float* w2 = args.in[I_FW2];
    const float fr = args.in[I_FFREQ][lane], b1 = args.in[I_FB1][lane], b2 = args.in[I_FB2][lane];
    for (int row = gw; row < LSEQ + CSEQ; row += NGW) {
        const float tt = row < LSEQ ? (float)row / (float)(LSEQ - 1) : (float)(row - LSEQ) / (float)(CSEQ - 1);
        float zv = 0.f;
        if (lane == 0) zv = tt;
        else if (lane <= 16) zv = cosf(6.283185307179586f * tt * (float)lane);
        else if (lane <= 32) zv = sinf(6.283185307179586f * tt * (float)(lane - 16));
        float a = b1;
        for (int e = 0; e < FEMB; ++e) a += __shfl(zv, e) * w1[e * FW + lane];
        const float h1 = sinf(fr * a);
        float c = b2;
        for (int i = 0; i < FW; ++i) c += __shfl(h1, i) * w2[i * FW + lane];
        WSP(float, WS_H2)[row * FW + lane] = sinf(fr * c);
    }
}
__device__ __forceinline__ void norm_rows(const Args& args, Frame& F, int which, bf16* A) {
    const int gw = F.bid * NWAVES + F.wave, NGW = F.G * NWAVES;
    const float* g = args.in[which == 0 ? I_NF1 : which == 1 ? I_NMIX : I_NF2];
    const int sh_off = which * 3 * DM, sc_off = sh_off + DM;
    for (int m0 = gw; m0 < MTOK; m0 += 2 * NGW) {
        f32x4 v[2][4];
#pragma unroll
        for (int q = 0; q < 2; ++q) { const int m = m0 + q * NGW < MTOK ? m0 + q * NGW : m0;
            const float* xrow = which == 0 ? (m < NCTX ? args.in[I_XP] + (size_t)m * DM : args.in[I_XS] + (size_t)(m - NCTX) * DM) : F.out + (size_t)m * DM;
#pragma unroll
            for (int j = 0; j < 4; ++j) v[q][j] = *((const f32x4*)xrow + F.lane + 64 * j); }
#pragma unroll
        for (int q = 0; q < 2; ++q) { const int m = m0 + q * NGW; if (m >= MTOK) break;
            const float* mod = WSP(float, WS_MOD) + mod_row(m) * MODW;
            float s = 0.f;
#pragma unroll
            for (int j = 0; j < 4; ++j) s += (v[q][j].x * v[q][j].x + v[q][j].y * v[q][j].y) + (v[q][j].z * v[q][j].z + v[q][j].w * v[q][j].w);
            const float rstd = 1.0f / sqrtf(wave_sum(s) * (1.0f / DM) + EPSF);
#pragma unroll
            for (int j = 0; j < 4; ++j) { const int c = 4 * F.lane + 256 * j;
                const f32x4 gg = *(const f32x4*)(g + c), sc = *(const f32x4*)(mod + sc_off + c), sh = *(const f32x4*)(mod + sh_off + c);
                const f32x4 y = v[q][j] * rstd * gg * (sc + 1.0f) + sh;
                u32x2 o; o.x = pk2(y.x, y.y); o.y = pk2(y.z, y.w);
                *(u32x2*)(A + (size_t)m * DM + c) = o; } }
    }
}
__device__ __forceinline__ void norm_rows_b(const Args& args, Frame& F, int which, const bf16* X, bf16* A) {
    const int gw = F.bid * NWAVES + F.wave, NGW = F.G * NWAVES;
    const float* g = args.in[which == 1 ? I_NMIX : I_NF2];
    const int sh_off = which * 3 * DM, sc_off = sh_off + DM;
    for (int m0 = gw; m0 < MTOK; m0 += 2 * NGW) {
        u32x4 p[2][2];
#pragma unroll
        for (int q = 0; q < 2; ++q)
#pragma unroll
            for (int j = 0; j < 2; ++j) p[q][j] = *(const u32x4*)(X + (size_t)(m0 + q * NGW < MTOK ? m0 + q * NGW : m0) * DM + 8 * F.lane + 512 * j);
#pragma unroll
        for (int q = 0; q < 2; ++q) { const int m = m0 + q * NGW; if (m >= MTOK) break;
            const float* mod = WSP(float, WS_MOD) + mod_row(m) * MODW;
            float v[2][8]; float s = 0.f;
#pragma unroll
            for (int j = 0; j < 2; ++j) { const u32x4 pp = p[q][j];
                v[j][0] = bf2f(pp.x & 0xffffu); v[j][1] = bf2f(pp.x >> 16); v[j][2] = bf2f(pp.y & 0xffffu); v[j][3] = bf2f(pp.y >> 16); v[j][4] = bf2f(pp.z & 0xffffu); v[j][5] = bf2f(pp.z >> 16); v[j][6] = bf2f(pp.w & 0xffffu); v[j][7] = bf2f(pp.w >> 16);
#pragma unroll
                for (int i = 0; i < 8; ++i) s += v[j][i] * v[j][i]; }
            const float rstd = 1.0f / sqrtf(wave_sum(s) * (1.0f / DM) + EPSF);
#pragma unroll
            for (int j = 0; j < 2; ++j) { const int c = 8 * F.lane + 512 * j; float y[8];
#pragma unroll
                for (int h = 0; h < 2; ++h) { const f32x4 gg = *(const f32x4*)(g + c + 4 * h), sc = *(const f32x4*)(mod + sc_off + c + 4 * h), sh = *(const f32x4*)(mod + sh_off + c + 4 * h);
#pragma unroll
                    for (int i = 0; i < 4; ++i) y[4 * h + i] = v[j][4 * h + i] * rstd * gg[i] * (sc[i] + 1.0f) + sh[i]; }
                u32x4 o; o.x = pk2(y[0], y[1]); o.y = pk2(y[2], y[3]); o.z = pk2(y[4], y[5]); o.w = pk2(y[6], y[7]);
                *(u32x4*)(A + (size_t)m * DM + c) = o; } }
    }
}
__device__ __forceinline__ void split_hl(const f32x4 a, const f32x4 b, bf16x8& hi, bf16x8& lo) {
    const float v[8] = {a.x, a.y, a.z, a.w, b.x, b.y, b.z, b.w}; unsigned h[8], l[8];
#pragma unroll
    for (int j = 0; j < 8; ++j) { h[j] = f2bf(v[j]); l[j] = f2bf(v[j] - bf2f(h[j])); }
    const u32x4 hv = {h[0] | (h[1] << 16), h[2] | (h[3] << 16), h[4] | (h[5] << 16), h[6] | (h[7] << 16)}, lv = {l[0] | (l[1] << 16), l[2] | (l[3] << 16), l[4] | (l[5] << 16), l[6] | (l[7] << 16)};
    hi = __builtin_bit_cast(bf16x8, hv); lo = __builtin_bit_cast(bf16x8, lv);
}
__device__ __forceinline__ void p1_taps(const Args& args, Frame& F, int cu0) {
    LAS float* red = (LAS float*)F.lds;
    LAS bf16* stg = (LAS bf16*)(F.lds + 1024) + F.wave * (32 * 40);
    const float* w3 = args.in[I_FW3]; const float* b3 = args.in[I_FB3]; const float* dec = args.in[I_FDEC];
    const int lane = F.lane, r = lane & 31, hh = lane >> 5;
    if (F.bid < cu0) return;
    for (int u = F.bid - cu0; u < 384; u += F.G - cu0) {
        const int ntype = u >= 256, uu = ntype ? u - 256 : u >> 1, half = ntype ? 0 : u & 1, o = (uu >> 6) & 1, c0 = (uu & 63) * 16;
        const int n = ntype ? CSEQ : LSEQ, off = n - 1;
        const int dir = r >> 4, c = c0 + (r & 15), col = o * 2048 + dir * 1024 + c;
        bf16x8 bh[4], bl[4];
#pragma unroll
        for (int kk = 0; kk < 4; ++kk) { const float* wp = w3 + (size_t)(16 * kk + 8 * hh) * 4096 + col;
            const f32x4 x0 = {wp[0], wp[4096], wp[2 * 4096], wp[3 * 4096]}, x1 = {wp[4 * 4096], wp[5 * 4096], wp[6 * 4096], wp[7 * 4096]};
            split_hl(x0, x1, bh[kk], bl[kk]); }
        const float bb = b3[col], dd = fabsf(dec[col]), rn = 1.0f / (float)(n - 1);
        const float* h2 = WSP(float, WS_H2) + (ntype ? LSEQ * FW : 0);
        bf16* G = ntype ? WSP(bf16, WS_TAPC) + (size_t)(o * 1024 + c0) * 512 : WSP(bf16, WS_TAPL) + (size_t)(o * 1024 + c0) * 8192;
        const int gstride = ntype ? 512 : 8192;
        float asum = 0.f;
        const int tile_lo = ntype ? 0 : half * 64, tile_hi = ntype ? 8 : tile_lo + 64;
        for (int tile = tile_lo + F.wave; tile < tile_hi; tile += NWAVES) {
            const int t0 = tile * 32;
            const f32x4* hr = (const f32x4*)(h2 + (size_t)(t0 + r) * FW + 8 * hh);
            f32x16 acc = {};
#pragma unroll
            for (int kk = 0; kk < 4; ++kk) { bf16x8 ah, al; split_hl(hr[4 * kk], hr[4 * kk + 1], ah, al);
                acc = __builtin_amdgcn_mfma_f32_32x32x16_bf16(ah, bh[kk], acc, 0, 0, 0);
                acc = __builtin_amdgcn_mfma_f32_32x32x16_bf16(al, bh[kk], acc, 0, 0, 0);
                acc = __builtin_amdgcn_mfma_f32_32x32x16_bf16(ah, bl[kk], acc, 0, 0, 0); }
#pragma unroll
            for (int q = 0; q < 16; ++q) { const int tr = (q & 3) + 8 * (q >> 2) + 4 * hh; const float a = (acc[q] + bb) * __expf(-(float)(t0 + tr) * rn * dd);
                asum += fabsf(a); stg[r * 40 + tr] = (bf16)f2bf(a); }
            LDS_WAIT(); asm volatile("" ::: "memory");
#pragma unroll 4
            for (int i = 0; i < 16; ++i) { const int cc = 2 * i + hh, cdir = cc >> 4, t = t0 + r; const bf16 v = stg[cc * 40 + r];
                bf16* Gc = G + (size_t)(cc & 15) * gstride;
                if (cdir == 0) Gc[off - t] = v; else if (t > 0) Gc[off + t] = v; }
            LDS_WAIT(); asm volatile("" ::: "memory");
        }
        if (F.wave == 0 && lane < 16 && (ntype || half)) G[(size_t)lane * gstride + 2 * off + 1] = 0;
        asum += __shfl_xor(asum, 32); asum += __shfl_xor(asum, 16);
        if (lane < 16) red[F.wave * 16 + lane] = asum;
        __syncthreads();
        if (F.tid < 16) { float sacc = 0.f;
#pragma unroll
            for (int w = 0; w < 8; ++w) sacc += red[w * 16 + F.tid];
            float* ps = WSP(float, WS_INVS) + ((ntype * 2 + o) * 1024 + c0 + F.tid) * 2;
            ps[half] = sacc; if (ntype) ps[1] = 0.f; }
        __syncthreads();
    }
}

template <int NB, class RM0, class RM1, class EPI>
__device__ __forceinline__ void sgemm(const Args& args, Frame& F, const bf16* A, const bf16* Bt, int M, int N, int K, RM0 rm0, RM1 rm1, EPI epi) {
    const int gw = F.bid * NWAVES + F.wave, NGW = F.G * NWAVES, r = F.lane & 31, hh = F.lane >> 5;
    const int tn_cnt = N / 32, ntile = (M / 32) * tn_cnt;
    for (int it = gw; it < ntile; it += NGW) {
        const int tm = it / tn_cnt, tn = it % tn_cnt;
        const bf16* ap = A + (size_t)(tm * 32 + r) * K + 8 * hh;
        const bf16* bp0 = Bt + (size_t)rm0(tn * 32 + r) * K + 8 * hh;
        const bf16* bp1 = Bt + (size_t)rm1(tn * 32 + r) * K + 8 * hh;
        f32x16 acc0 = {}, acc1 = {};
#pragma unroll 4
        for (int k0 = 0; k0 < K; k0 += 16) {
            const bf16x8 a = *(const bf16x8*)(ap + k0), b0 = *(const bf16x8*)(bp0 + k0);
            acc0 = __builtin_amdgcn_mfma_f32_32x32x16_bf16(a, b0, acc0, 0, 0, 0);
            if (NB == 2) { const bf16x8 b1 = *(const bf16x8*)(bp1 + k0); acc1 = __builtin_amdgcn_mfma_f32_32x32x16_bf16(a, b1, acc1, 0, 0, 0); }
        }
#pragma unroll
        for (int q = 0; q < 16; ++q) epi(tm * 32 + (q & 3) + 8 * (q >> 2) + 4 * hh, tn * 32 + r, acc0[q], acc1[q]);
    }
}
struct RmId { __device__ __forceinline__ int operator()(int n) const { return n; } };
struct RmGate { __device__ __forceinline__ int operator()(int j) const { return map_swiglu(j); } };
struct RmUp { __device__ __forceinline__ int operator()(int j) const { return map_swiglu(DFF + j); } };

struct EpiSwiglu { bf16* U; __device__ __forceinline__ void operator()(int row, int col, float g, float u) const { U[(size_t)row * DFF + col] = (bf16)f2bf(g / (1.0f + __expf(-g)) * u); } };
struct EpiRes0 { const float* xp; const float* xs; float* out; const float* mod; int goff; float coef;
    __device__ __forceinline__ void operator()(int row, int col, float v, float) const {
        const float xin = row < NCTX ? xp[(size_t)row * DM + col] : xs[(size_t)(row - NCTX) * DM + col];
        out[(size_t)row * DM + col] = xin + coef * mod[mod_row(row) * MODW + goff + col] * v; } };
struct EpiRes1 { float* out; const float* mod; int goff; float coef;
    __device__ __forceinline__ void operator()(int row, int col, float v, float) const {
        out[(size_t)row * DM + col] += coef * mod[mod_row(row) * MODW + goff + col] * v; } };

struct RmHeadLo { __device__ __forceinline__ int operator()(int n) const { const int hd = n >> 5, d = n & 31; return map_qkv(hd * 64 + d); } };
struct RmHeadHi { __device__ __forceinline__ int operator()(int n) const { const int hd = n >> 5, d = n & 31; return map_qkv(hd * 64 + 32 + d); } };
constexpr float C2 = 0.125f * 1.4426950408889634f;

__device__ __forceinline__ void qkv_naive(const Args& args, Frame& F) {
    const bf16* A = WSP(bf16, WS_A); const bf16* Bt = WSP(bf16, WS_WQKV);
    const int gw = F.bid * NWAVES + F.wave, NGW = F.G * NWAVES, r = F.lane & 31, hh = F.lane >> 5;
    const int ntile = (MTOK / 32) * 24;
    const float qn_lo = args.in[I_QN][r], qn_hi = args.in[I_QN][32 + r], kn_lo = args.in[I_KN][r], kn_hi = args.in[I_KN][32 + r];
    const float invf = __powf(10000.0f, -(float)(r & 15) / 16.0f);
    for (int it = gw; it < ntile; it += NGW) {
        const int tm = it / 24, hd = it % 24;
        const bf16* ap = A + (size_t)(tm * 32 + r) * DM + 8 * hh;
        const bf16* bp0 = Bt + (size_t)map_qkv(hd * 64 + r) * DM + 8 * hh;
        const bf16* bp1 = Bt + (size_t)map_qkv(hd * 64 + 32 + r) * DM + 8 * hh;
        f32x16 a0 = {}, a1 = {};
#pragma unroll 4
        for (int k0 = 0; k0 < DM; k0 += 16) { const bf16x8 a = *(const bf16x8*)(ap + k0);
            a0 = __builtin_amdgcn_mfma_f32_32x32x16_bf16(a, *(const bf16x8*)(bp0 + k0), a0, 0, 0, 0);
            a1 = __builtin_amdgcn_mfma_f32_32x32x16_bf16(a, *(const bf16x8*)(bp1 + k0), a1, 0, 0, 0); }
#pragma unroll
        for (int q = 0; q < 16; ++q) {
            const int row = tm * 32 + (q & 3) + 8 * (q >> 2) + 4 * hh;
            float lo = a0[q], hi = a1[q];
            const bool lat = row >= NCTX; const int t = (row - NCTX) & (LSEQ - 1), bl = (row - NCTX) >> 12;
            if (hd < 20) {
                float ss = lo * lo + hi * hi;
#pragma unroll
                for (int o = 1; o < 32; o <<= 1) ss += __shfl_xor(ss, o);
                const float rs = 1.0f / sqrtf(ss * (1.0f / 64.0f) + EPSF);
                lo *= rs * (hd < 16 ? qn_lo : kn_lo); hi *= rs * (hd < 16 ? qn_hi : kn_hi);
                if (!lat && hd >= 16) { F.out[OUT_NK + (size_t)row * KVW + (hd - 16) * 64 + r] = lo; F.out[OUT_NK + (size_t)row * KVW + (hd - 16) * 64 + 32 + r] = hi; }
                const float plo = __shfl_xor(lo, 16), phi = __shfl_xor(hi, 16);
                if (lat) {
                    const float angr = (float)(t >> 6) * invf, angc = (float)(t & 63) * invf;
                    const float cr = cosf(angr), sr = sinf(angr), cc = cosf(angc), sc = sinf(angc);
                    lo = (r & 16) ? lo * cr + plo * sr : lo * cr - plo * sr;
                    hi = (r & 16) ? hi * cc + phi * sc : hi * cc - phi * sc;
                }
            } else if (!lat) { F.out[OUT_NV + (size_t)row * KVW + (hd - 20) * 64 + r] = lo; F.out[OUT_NV + (size_t)row * KVW + (hd - 20) * 64 + 32 + r] = hi; }
            if (hd < 16) { bf16* Q = WSP(bf16, WS_Q) + (size_t)row * DM + hd * 64; Q[r] = (bf16)f2bf(lo * C2); Q[32 + r] = (bf16)f2bf(hi * C2); }
            else {
                const int kvh = (hd - 16) & 3; const bool isk = hd < 20;
                bf16* dst = lat ? WSP(bf16, isk ? WS_KL : WS_VL) + ((size_t)bl * KLROWS + PAST + t) * KVW : WSP(bf16, isk ? WS_KC : WS_VC) + (size_t)row * KVW;
                dst[kvh * 64 + r] = (bf16)f2bf(lo); dst[kvh * 64 + 32 + r] = (bf16)f2bf(hi);
            }
        }
    }
}
__device__ __forceinline__ void cache_rows(const Args& args, Frame& F, int cu0) {
    if (F.bid < cu0) return;
    const size_t gt = (size_t)(F.bid - cu0) * NTHR + F.tid, NGT = (size_t)(F.G - cu0) * NTHR;
    for (size_t i = gt; i < (size_t)8 * PAST * KVW / 4; i += NGT) {
        const size_t e = i * 4, bl = e / (PAST * KVW), rem = e % (PAST * KVW);
        const f32x4 k = *(const f32x4*)(args.in[I_CK] + e), v = *(const f32x4*)(args.in[I_CV] + e);
        u32x2 ko, vo; ko.x = pk2(k.x, k.y); ko.y = pk2(k.z, k.w); vo.x = pk2(v.x, v.y); vo.y = pk2(v.z, v.w);
        *(u32x2*)(WSP(bf16, WS_KL) + bl * KLROWS * KVW + rem) = ko; *(u32x2*)(WSP(bf16, WS_VL) + bl * KLROWS * KVW + rem) = vo;
    }
    for (size_t i = gt; i < (size_t)8 * KLPAD * KVW / 4; i += NGT) {
        const size_t e = i * 4, bl = e / (KLPAD * KVW), rem = e % (KLPAD * KVW);
        u32x2 z; z.x = 0; z.y = 0;
        *(u32x2*)(WSP(bf16, WS_KL) + (bl * KLROWS + PAST + LSEQ) * KVW + rem) = z; *(u32x2*)(WSP(bf16, WS_VL) + (bl * KLROWS + PAST + LSEQ) * KVW + rem) = z;
    }
}
struct EpiHyT { bf16* H; __device__ __forceinline__ void operator()(int row, int col, float v, float) const { H[(size_t)row * MTOK + col] = (bf16)f2bf(v); } };

__device__ __forceinline__ void attn_naive(const Args& args, Frame& F) {
    const size_t gt = (size_t)F.bid * NTHR + F.tid, NGT = (size_t)F.G * NTHR;
    for (size_t idx = gt; idx < (size_t)MTOK * NH; idx += NGT) {
        const int h = (int)(idx / MTOK), m = (int)(idx % MTOK), kvh = h >> 2;
        const bool lat = m >= NCTX; const int t = (m - NCTX) & (LSEQ - 1), bl = (m - NCTX) >> 12;
        bf16* qp = WSP(bf16, WS_Q) + (size_t)m * DM + h * 64;
        float q[64], o[64];
#pragma unroll
        for (int d = 0; d < 64; ++d) { q[d] = bf2f(qp[d]); o[d] = 0.f; }
        const bf16* kb; const bf16* vb; int k_lo, k_hi;
        if (lat) { kb = WSP(bf16, WS_KL) + (size_t)bl * KLROWS * KVW + kvh * 64; vb = WSP(bf16, WS_VL) + (size_t)bl * KLROWS * KVW + kvh * 64;
            const int a = t - WIN < 0 ? 0 : t - WIN, b = t + WIN > LSEQ - 1 ? LSEQ - 1 : t + WIN; k_lo = PAST + a; k_hi = PAST + b + 1; }
        else { const int bc = m >> 8; kb = WSP(bf16, WS_KC) + (size_t)bc * CSEQ * KVW + kvh * 64; vb = WSP(bf16, WS_VC) + (size_t)bc * CSEQ * KVW + kvh * 64; k_lo = 0; k_hi = CSEQ; }
        float mx = args.in[I_SINK][h] * 1.4426950408889634f, l = 1.0f;
        const int n1 = lat ? PAST : 0;
        for (int pass = 0; pass < 2; ++pass) {
            const int lo = pass == 0 ? 0 : k_lo, hi = pass == 0 ? n1 : k_hi;
            for (int kr = lo; kr < hi; ++kr) {
                const bf16* kp = kb + (size_t)kr * KVW; const bf16* vp = vb + (size_t)kr * KVW;
                float s = 0.f;
#pragma unroll
                for (int d8 = 0; d8 < 8; ++d8) { const u32x4 kk = *(const u32x4*)(kp + 8 * d8);
                    s += q[8 * d8] * bf2f(kk.x & 0xffff) + q[8 * d8 + 1] * bf2f(kk.x >> 16) + q[8 * d8 + 2] * bf2f(kk.y & 0xffff) + q[8 * d8 + 3] * bf2f(kk.y >> 16)
                       + q[8 * d8 + 4] * bf2f(kk.z & 0xffff) + q[8 * d8 + 5] * bf2f(kk.z >> 16) + q[8 * d8 + 6] * bf2f(kk.w & 0xffff) + q[8 * d8 + 7] * bf2f(kk.w >> 16); }
                const float mn = fmaxf(mx, s), f = exp2f(mx - mn), p = exp2f(s - mn);
                l = l * f + p; mx = mn;
#pragma unroll
                for (int d8 = 0; d8 < 8; ++d8) { const u32x4 vv = *(const u32x4*)(vp + 8 * d8);
                    o[8 * d8] = o[8 * d8] * f + p * bf2f(vv.x & 0xffff); o[8 * d8 + 1] = o[8 * d8 + 1] * f + p * bf2f(vv.x >> 16);
                    o[8 * d8 + 2] = o[8 * d8 + 2] * f + p * bf2f(vv.y & 0xffff); o[8 * d8 + 3] = o[8 * d8 + 3] * f + p * bf2f(vv.y >> 16);
                    o[8 * d8 + 4] = o[8 * d8 + 4] * f + p * bf2f(vv.z & 0xffff); o[8 * d8 + 5] = o[8 * d8 + 5] * f + p * bf2f(vv.z >> 16);
                    o[8 * d8 + 6] = o[8 * d8 + 6] * f + p * bf2f(vv.w & 0xffff); o[8 * d8 + 7] = o[8 * d8 + 7] * f + p * bf2f(vv.w >> 16); }
            }
        }
        const float il = 1.0f / l;
#pragma unroll
        for (int d = 0; d < 64; d += 2) *(unsigned*)(qp + d) = pk2(o[d] * il, o[d + 1] * il);
    }
}
__device__ __forceinline__ float hy_u(const bf16* rowp, int t, int n, const float* cw, int ch, float cb) {
    const float a = t > 0 ? bf2f(rowp[t - 1]) : 0.f, b = bf2f(rowp[t]), c = t + 1 < n ? bf2f(rowp[t + 1]) : 0.f;
    return a * cw[ch] + b * cw[NHY + ch] + c * cw[2 * NHY + ch] + cb;
}
__device__ __forceinline__ void hyena_naive(const Args& args, Frame& F) {
    LAS float* kt = (LAS float*)F.lds;
    LAS float* z = kt + 8192;
    LAS float* y = z + 4096;
    const float* cw = args.in[I_CW]; const float* cbv = args.in[I_CB];
    const int NU = 1024 * 8 + 1024 * 16;
    for (int u = F.bid; u < NU; u += F.G) {
        const bool lat = u < 8192; const int c = lat ? u >> 3 : (u - 8192) >> 4, b = lat ? u & 7 : (u - 8192) & 15;
        const int n = lat ? LSEQ : CSEQ, off = n - 1;
        const size_t tok0 = lat ? (size_t)NCTX + (size_t)b * LSEQ : (size_t)b * CSEQ;
        const bf16* r1 = WSP(bf16, WS_HYT) + (size_t)c * MTOK + tok0; const bf16* r2 = r1 + (size_t)1024 * MTOK; const bf16* r3 = r1 + (size_t)2048 * MTOK;
        for (int t = F.tid; t < n; t += NTHR) z[t] = bf2f(f2bf(hy_u(r3, t, n, cw, 2048 + c, cbv[2048 + c])));
        for (int o = 0; o < 2; ++o) {
            const bf16* G = lat ? WSP(bf16, WS_TAPL) + (size_t)(o * 1024 + c) * 8192 : WSP(bf16, WS_TAPC) + (size_t)(o * 1024 + c) * 512;
            const float* ps = WSP(float, WS_INVS) + (((lat ? 0 : 1) * 2 + o) * 1024 + c) * 2;
            const float invs = 1.0f / (ps[0] + ps[1] + EPSF), skip = args.in[I_HSKIP][o * 1024 + c];
            __syncthreads();
            for (int i = F.tid; i < 2 * n - 1; i += NTHR) { float kv = bf2f(G[i]) * invs; if (i == off) kv += skip; kt[2 * off - i] = bf2f(f2bf(kv)); }
            __syncthreads();
            for (int t = F.tid; t < n; t += NTHR) { float a = 0.f; for (int s = 0; s < n; ++s) a += kt[t - s + off] * z[s]; y[t] = a; }
            __syncthreads();
            if (o == 0) { for (int t = F.tid; t < n; t += NTHR) z[t] = bf2f(f2bf(hy_u(r1, t, n, cw, c, cbv[c]) * y[t])); }
            else { for (int t = F.tid; t < n; t += NTHR) y[t] = hy_u(r2, t, n, cw, 1024 + c, cbv[1024 + c]) * y[t]; }
        }
        __syncthreads();
        bf16* dst = WSP(bf16, WS_HYT) + (size_t)c * MTOK + tok0;
        for (int t = F.tid; t < n; t += NTHR) dst[t] = (bf16)f2bf(y[t]);
        __syncthreads();
    }
}
template <bool LAT> struct HyGeo {
    static constexpr int NSEQ = LAT ? 4096 : 256, NBT = LAT ? 8 : 16, NCH = LAT ? 1 : 4, ZB = NSEQ + 6 * 64 + 8, CS = NSEQ + 16  , NCOPY = 4, OFF = NSEQ - 1, NT = LAT ? 2 : 1;
    static constexpr int ZBYTES = NBT * ZB * 2, TAPBYTES = (NCOPY * CS * 4 + 15) & ~15, CHBYTES = ZBYTES + TAPBYTES;
    static_assert(ZBYTES % 16 == 0 && CHBYTES % 16 == 0 && (ZB / 2) % 64 == 4 && CS % 64 == 16 && NCH * CHBYTES <= 147392 - 64, "hyena LDS geometry");
};
__device__ __forceinline__ float bflo_(unsigned w) { return __builtin_bit_cast(float, w << 16); }
__device__ __forceinline__ float bfhi_(unsigned w) { return __builtin_bit_cast(float, w & 0xffff0000u); }
__device__ __forceinline__ unsigned pkbf(float lo, float hi) { typedef float f2 __attribute__((ext_vector_type(2))); typedef __bf16 b2 __attribute__((ext_vector_type(2))); f2 v = {lo, hi}; b2 b = __builtin_convertvector(v, b2); return __builtin_bit_cast(unsigned, b); }
__device__ __forceinline__ f32x4 sconv4(u32x2 cur, float l, float r, float w0, float w1, float w2, float cb) {
    const float u0 = bflo_(cur.x), u1 = bfhi_(cur.x), u2 = bflo_(cur.y), u3 = bfhi_(cur.y);
    f32x4 y; y.x = w0 * l + w1 * u0 + w2 * u1 + cb; y.y = w0 * u0 + w1 * u1 + w2 * u2 + cb; y.z = w0 * u1 + w1 * u2 + w2 * u3 + cb; y.w = w0 * u2 + w1 * u3 + w2 * r + cb; return y;
}
template <int NT, bool T0, bool T1> __device__ __forceinline__ void toep_range(f32x16 (&acc)[NT][2], LAS const unsigned char* ab, LAS const unsigned char* zb, int ds, int de) {
    bf16x8 afA[6], afB[6], bfA[2][4], bfB[2][4];
#define HY_LA(AF, AP, DL) do { LAS const u32x2* p_ = (LAS const u32x2*)((AP) + ((DL) - 2) * 8); const u32x2 l_ = p_[0], h_ = p_[1]; const u32x4 t_ = {l_.x, l_.y, h_.x, h_.y}; AF[DL] = __builtin_bit_cast(bf16x8, t_); } while (0)
#define HY_LB(BF, ZP, KK) do { if (T0) BF[0][KK] = *(LAS const bf16x8*)((ZP) + (KK) * 32); if (T1) BF[1][KK] = *(LAS const bf16x8*)((ZP) + 512 + (KK) * 32); } while (0)
#define HY_LG(AF, BF, AP, ZP, G) do { if ((G) == 0) { HY_LA(AF, AP, 0); HY_LA(AF, AP, 2); } else if ((G) == 1) { HY_LA(AF, AP, 1); HY_LA(AF, AP, 3); } else if ((G) == 2) { HY_LA(AF, AP, 4); } else { HY_LA(AF, AP, 5); } \
        HY_LB(BF, ZP, G); } while (0)
#define HY_MG(AF, BF, KK) do { \
        if (T0) { acc[0][0] = __builtin_amdgcn_mfma_f32_32x32x16_bf16(AF[(KK) + 2], BF[0][KK], acc[0][0], 0, 0, 0); acc[0][1] = __builtin_amdgcn_mfma_f32_32x32x16_bf16(AF[KK], BF[0][KK], acc[0][1], 0, 0, 0); } \
        if (T1) { acc[NT - 1][0] = __builtin_amdgcn_mfma_f32_32x32x16_bf16(AF[(KK) + 2], BF[1][KK], acc[NT - 1][0], 0, 0, 0); acc[NT - 1][1] = __builtin_amdgcn_mfma_f32_32x32x16_bf16(AF[KK], BF[1][KK], acc[NT - 1][1], 0, 0, 0); } } while (0)
#define HY_STEP(AFC, BFC, AFN, BFN, DN) do { const int dn_ = (DN); LAS const unsigned* apn_ = (LAS const unsigned*)(ab - dn_ * 128); LAS const unsigned char* zpn_ = zb - dn_ * 128; \
        _Pragma("unroll") for (int g_ = 0; g_ < 4; ++g_) { HY_LG(AFN, BFN, apn_, zpn_, g_); __builtin_amdgcn_sched_barrier(0); HY_MG(AFC, BFC, g_); __builtin_amdgcn_sched_barrier(0); } } while (0)
    { LAS const unsigned* ap0 = (LAS const unsigned*)(ab - ds * 128); LAS const unsigned char* zp0 = zb - ds * 128;
#pragma unroll
      for (int g = 0; g < 4; ++g) HY_LG(afA, bfA, ap0, zp0, g); }
    int D = ds;
#pragma unroll 1
    for (; D + 1 <= de; D += 2) {
        HY_STEP(afA, bfA, afB, bfB, D + 1);
        HY_STEP(afB, bfB, afA, bfA, (D + 2 <= de ? D + 2 : de));
    }
    if (D == de) {
#pragma unroll
        for (int g = 0; g < 4; ++g) HY_MG(afA, bfA, g);
    }
#undef HY_LA
#undef HY_LB
#undef HY_LG
#undef HY_MG
#undef HY_STEP
}
template <int NT> __device__ __forceinline__ void toep_conv(f32x16 (&acc)[NT][2], LAS const unsigned char* ab, LAS const unsigned char* zb, int d_lo, int d_hi, int t0_hi, int t1_lo) {
    if (NT == 1) { toep_range<NT, true, false>(acc, ab, zb, d_lo, d_hi); return; }
    toep_range<NT, true, false>(acc, ab, zb, d_lo, t1_lo - 1);
    toep_range<NT, true, true>(acc, ab, zb, t1_lo, t0_hi);
    toep_range<NT, false, true>(acc, ab, zb, t0_hi + 1, d_hi);
}
template <bool LAT> __device__ __forceinline__ void hyena_fast(const Args& args, Frame& F, bool dry = false) {
    typedef HyGeo<LAT> H;
    constexpr int NSEQ = H::NSEQ, NBT = H::NBT, NCH = H::NCH, ZB = H::ZB, CS = H::CS, OFF = H::OFF, NT = H::NT;
    constexpr int NV = NCH * NBT * NSEQ / 8 / NTHR;
    constexpr int NTC = NCH * (NSEQ * 2 / 16);
    const float* cw = args.in[I_CW]; const float* cbv = args.in[I_CB];
    const int lane = F.lane, r = lane & 31, hh = lane >> 5, w = F.wave;
    const int mych = LAT ? 0 : (w >> 1);
    LAS unsigned char* zreg = F.lds + mych * H::CHBYTES; LAS unsigned char* treg = zreg + H::ZBYTES;
    const int s0 = OFF - r + 8 * hh;
    const int cpy = s0 & 3;
    LAS const unsigned char* ab = treg + cpy * (CS * 4) + 2 * (s0 - cpy);
    const int tl = r >> 3, bcol = (LAT ? 0 : 8 * (w & 1)) + (r & 7), T0 = LAT ? 8 * w : 0;
    LAS const unsigned char* zb = zreg + 2 * (bcol * ZB + (T0 + tl + 3) * 64 + 8 * hh);
    const int d_lo = LAT ? 8 * w - 63 : -3, d_hi = LAT ? 8 * w + 7 : 3, t0_hi = 8 * w + 3, t1_lo = 8 * w - 59;
    const size_t tokb = LAT ? (size_t)NCTX : 0;
    bf16* rows = WSP(bf16, WS_HYT) + tokb;
    const int NU = 1024 / NCH;
    if (F.bid >= NU) return;
    for (int q = F.tid; q < NCH * NBT * 49; q += NTHR) {
        const int ch = q / (NBT * 49), b = (q / 49) % NBT, i = q % 49; const u32x4 zz = {0u, 0u, 0u, 0u};
        *(LAS u32x4*)(F.lds + ch * H::CHBYTES + 2 * (b * ZB + (i < 24 ? i * 8 : 192 + NSEQ + (i - 24) * 8))) = zz;
    }
    u32x4 vcur[NV]; unsigned vnb[NV];
    u32x4 tg0, tg1; u32x2 tgx; float tinv = 0.f, tskip = 0.f;
#define HY_VISSUE(C0) do { _Pragma("unroll") for (int i = 0; i < NV; ++i) { const int q = tid_ + i * NTHR, ch = q / (NBT * NSEQ / 8), b = (q / (NSEQ / 8)) % NBT, t0 = (q % (NSEQ / 8)) * 8; \
        const bf16* rp = rows + (size_t)(2048 + (C0) + ch) * MTOK + (size_t)b * NSEQ + t0; vcur[i] = *(const u32x4*)rp; vnb[i] = (unsigned)rp[-1] | ((unsigned)rp[8] << 16); } } while (0)
#define HY_VWRITE(C0) do { _Pragma("unroll") for (int i = 0; i < NV; ++i) { const int q = tid_ + i * NTHR, ch = q / (NBT * NSEQ / 8), b = (q / (NSEQ / 8)) % NBT, t0 = (q % (NSEQ / 8)) * 8, c = (C0) + ch; \
        const float l = t0 > 0 ? bflo_(vnb[i]) : 0.f, rr = t0 + 8 < NSEQ ? bfhi_(vnb[i]) : 0.f; \
        const float w0 = cw[2048 + c], w1 = cw[NHY + 2048 + c], w2 = cw[2 * NHY + 2048 + c], cb = cbv[2048 + c]; \
        u32x2 lo2, hi2; lo2.x = vcur[i].x; lo2.y = vcur[i].y; hi2.x = vcur[i].z; hi2.y = vcur[i].w; \
        const f32x4 ya = sconv4(lo2, l, bflo_(vcur[i].z), w0, w1, w2, cb), yb = sconv4(hi2, bfhi_(vcur[i].y), rr, w0, w1, w2, cb); \
        u32x4 o_; o_.x = pkbf(ya.x, ya.y); o_.y = pkbf(ya.z, ya.w); o_.z = pkbf(yb.x, yb.y); o_.w = pkbf(yb.z, yb.w); \
        *(LAS u32x4*)(F.lds + ch * H::CHBYTES + 2 * (b * ZB + 192 + t0)) = o_; } } while (0)
#define HY_TISSUE(O, C0) do { if (tid_ < NTC) { const int ch = tid_ / (NSEQ * 2 / 16), i0 = (tid_ % (NSEQ * 2 / 16)) * 16, c = (C0) + ch; \
        const bf16* G = LAT ? WSP(bf16, WS_TAPL) + (size_t)((O) * 1024 + c) * 8192 : WSP(bf16, WS_TAPC) + (size_t)((O) * 1024 + c) * 512; \
        const float* ps = WSP(float, WS_INVS) + (((LAT ? 0 : 1) * 2 + (O)) * 1024 + c) * 2; \
        tinv = 1.0f / (ps[0] + ps[1] + EPSF); tskip = args.in[I_HSKIP][(O) * 1024 + c]; \
        tg0 = *(const u32x4*)(G + i0); tg1 = *(const u32x4*)(G + i0 + 8); tgx = i0 + 16 < NSEQ * 2 ? *(const u32x2*)(G + i0 + 16) : (u32x2){0u, 0u}; } } while (0)
#define HY_TWRITE() do { if (tid_ < NTC) { const int ch = tid_ / (NSEQ * 2 / 16), i0 = (tid_ % (NSEQ * 2 / 16)) * 16; \
        float v[20] = {bflo_(tg0.x), bfhi_(tg0.x), bflo_(tg0.y), bfhi_(tg0.y), bflo_(tg0.z), bfhi_(tg0.z), bflo_(tg0.w), bfhi_(tg0.w), \
                       bflo_(tg1.x), bfhi_(tg1.x), bflo_(tg1.y), bfhi_(tg1.y), bflo_(tg1.z), bfhi_(tg1.z), bflo_(tg1.w), bfhi_(tg1.w), bflo_(tgx.x), bfhi_(tgx.x), bflo_(tgx.y), 0.f}; \
        _Pragma("unroll") for (int j = 0; j < 19; ++j) { v[j] *= tinv; if (i0 + j == OFF) v[j] += tskip; } \
        LAS unsigned char* tb = F.lds + ch * H::CHBYTES + H::ZBYTES; \
        _Pragma("unroll") for (int cc = 0; cc < 4; ++cc) { \
            u32x4 a0, a1; a0.x = pkbf(v[cc], v[cc + 1]); a0.y = pkbf(v[cc + 2], v[cc + 3]); a0.z = pkbf(v[cc + 4], v[cc + 5]); a0.w = pkbf(v[cc + 6], v[cc + 7]); \
            a1.x = pkbf(v[cc + 8], v[cc + 9]); a1.y = pkbf(v[cc + 10], v[cc + 11]); a1.z = pkbf(v[cc + 12], v[cc + 13]); a1.w = pkbf(v[cc + 14], v[cc + 15]); \
            *(LAS u32x4*)(tb + cc * (CS * 4) + 2 * i0) = a0; *(LAS u32x4*)(tb + cc * (CS * 4) + 2 * i0 + 16) = a1; } } } while (0)
    u32x4 xq[NT][8]; unsigned xe[NT];
#define HY_XISSUE(RT, C) do { const bf16* rpl = rows + (size_t)((RT) * 1024 + (C)) * MTOK + (size_t)bcol * NSEQ + 64 * (T0 + tl); \
        _Pragma("unroll") for (int t = 0; t < NT; ++t) { const bf16* rp = rpl + 256 * t; \
            _Pragma("unroll") for (int k = 0; k < 8; ++k) xq[t][k] = *(const u32x4*)(rp + 8 * k); \
            xe[t] = (unsigned)rp[-1] | ((unsigned)rp[64] << 16); } } while (0)
#define HY_EPI(RT, C) do { const float w0 = cw[(RT) * 1024 + (C)], w1 = cw[NHY + (RT) * 1024 + (C)], w2 = cw[2 * NHY + (RT) * 1024 + (C)], cb = cbv[(RT) * 1024 + (C)]; \
        _Pragma("unroll") for (int t = 0; t < NT; ++t) _Pragma("unroll") for (int ih = 0; ih < 2; ++ih) _Pragma("unroll") for (int g = 0; g < 4; ++g) { \
            const int k = 4 * ih + g, tt = 64 * (T0 + 4 * t + tl) + 8 * k + 4 * hh; \
            const u32x4 q_ = xq[t][k]; u32x2 cur; cur.x = hh ? q_.z : q_.x; cur.y = hh ? q_.w : q_.y; \
            const unsigned lw = k > 0 ? xq[t][k > 0 ? k - 1 : 0].w : (xe[t] << 16), rw = k < 7 ? xq[t][k < 7 ? k + 1 : 7].x : (xe[t] >> 16); \
            float l = hh ? bfhi_(q_.y) : bfhi_(lw), rr = hh ? bflo_(rw) : bflo_(q_.z); \
            if (tt == 0) l = 0.f; if (tt + 4 == NSEQ) rr = 0.f; \
            const f32x4 x = sconv4(cur, l, rr, w0, w1, w2, cb); \
            u32x2 ov; ov.x = pkbf(x.x * acc[t][ih][4 * g], x.y * acc[t][ih][4 * g + 1]); ov.y = pkbf(x.z * acc[t][ih][4 * g + 2], x.w * acc[t][ih][4 * g + 3]); \
            *(LAS u32x2*)(zreg + 2 * (bcol * ZB + 192 + tt)) = ov; } } while (0)
#define HY_CONV(RT, C, EARLY) do { _Pragma("unroll") for (int t = 0; t < NT; ++t) { acc[t][0] = f32x16{}; acc[t][1] = f32x16{}; } \
        if (NT == 1) { HY_XISSUE(RT, C); if (!(DRY_NOCONV && dry)) toep_range<NT, true, false>(acc, ab, zb, d_lo, d_hi); } \
        else { if (!(DRY_NOCONV && dry)) { toep_range<NT, true, false>(acc, ab, zb, d_lo, t1_lo - 1); toep_range<NT, true, true>(acc, ab, zb, t1_lo, t0_hi); } \
               if (EARLY) HY_XISSUE(RT, C); if (!(DRY_NOCONV && dry)) toep_range<NT, false, true>(acc, ab, zb, t0_hi + 1, d_hi); if (!(EARLY)) HY_XISSUE(RT, C); } } while (0)
    f32x16 acc[NT][2];
    int tid_ = F.tid; asm volatile("" : "+v"(tid_));
    { const int c0 = F.bid * NCH; HY_VISSUE(c0); HY_TISSUE(0, c0); HY_VWRITE(c0); HY_TWRITE(); }
    __syncthreads();
#pragma unroll 1
    for (int u = F.bid; u < NU; u += F.G) {
        const int c0 = u * NCH, c = c0 + mych, un = u + F.G; const bool has_next = un < NU;
        asm volatile("" : "+v"(tid_));
        HY_CONV(0, c, false);
        __builtin_amdgcn_sched_barrier(0);
        HY_TISSUE(1, c0);
        __syncthreads();
        HY_EPI(0, c); HY_TWRITE();
        __syncthreads();
        HY_CONV(1, c, false);
        __syncthreads();
        HY_EPI(1, c);
        __builtin_amdgcn_sched_barrier(0);
        { const int cn = (has_next ? un : u) * NCH; HY_VISSUE(cn); HY_TISSUE(0, cn); }
        __syncthreads();
        for (int q = tid_; q < NCH * NBT * NSEQ / 8; q += NTHR) {
            const int ch = q / (NBT * NSEQ / 8), b = (q / (NSEQ / 8)) % NBT, t0 = (q % (NSEQ / 8)) * 8;
            const u32x4 o = *(LAS const u32x4*)(F.lds + ch * H::CHBYTES + 2 * (b * ZB + 192 + t0));
            if (!dry) *(u32x4*)(rows + (size_t)(c0 + ch) * MTOK + (size_t)b * NSEQ + t0) = o;
        }
        __syncthreads();
        if (has_next) { HY_VWRITE(un * NCH); HY_TWRITE(); }
        __syncthreads();
    }
#undef HY_VISSUE
#undef HY_VWRITE
#undef HY_TISSUE
#undef HY_TWRITE
#undef HY_XISSUE
#undef HY_EPI
#undef HY_CONV
}
typedef float f32x2 __attribute__((ext_vector_type(2)));
namespace hfft {
constexpr int N = 8192, BUFC = N + 2 * (N >> 5)  , BUFB = BUFC * 8;
struct cpx { float x, y; };
template <int E, bool INV> __device__ __forceinline__ void bfly(cpx& p, cpx& q) {
    constexpr float C1 = 0.92387953251f, S1 = 0.38268343236f, H = 0.70710678118f;
    const float ax = p.x, ay = p.y, bx = q.x, by = q.y; float px, py, qx, qy, t0, t1;
    if constexpr (E == 0) asm("v_add_f32 %0, %4, %6\n\tv_add_f32 %1, %5, %7\n\tv_sub_f32 %2, %4, %6\n\tv_sub_f32 %3, %5, %7" : "=&v"(px), "=&v"(py), "=&v"(qx), "=&v"(qy) : "v"(ax), "v"(ay), "v"(bx), "v"(by));
    else if constexpr (E == 4) { if (INV) asm("v_add_f32 %0, %4, %6\n\tv_add_f32 %1, %5, %7\n\tv_sub_f32 %2, %7, %5\n\tv_sub_f32 %3, %4, %6" : "=&v"(px), "=&v"(py), "=&v"(qx), "=&v"(qy) : "v"(ax), "v"(ay), "v"(bx), "v"(by));
        else asm("v_add_f32 %0, %4, %6\n\tv_add_f32 %1, %5, %7\n\tv_sub_f32 %2, %5, %7\n\tv_sub_f32 %3, %6, %4" : "=&v"(px), "=&v"(py), "=&v"(qx), "=&v"(qy) : "v"(ax), "v"(ay), "v"(bx), "v"(by)); }
    else if constexpr (E == 2 || E == 6) {
        constexpr float hx = (E == 6 && INV) ? -H : H, hy = (E == 6 && !INV) ? -H : H;
        if ((E == 2 && !INV) || (E == 6 && INV))
            asm("v_add_f32 %0, %6, %8\n\tv_add_f32 %1, %7, %9\n\tv_sub_f32 %4, %6, %8\n\tv_sub_f32 %5, %7, %9\n\tv_add_f32 %2, %4, %5\n\tv_sub_f32 %3, %5, %4\n\tv_mul_f32 %2, %10, %2\n\tv_mul_f32 %3, %11, %3"
                : "=&v"(px), "=&v"(py), "=&v"(qx), "=&v"(qy), "=&v"(t0), "=&v"(t1) : "v"(ax), "v"(ay), "v"(bx), "v"(by), "s"(hx), "s"((E == 6 && INV) ? -hy : hy));
        else
            asm("v_add_f32 %0, %6, %8\n\tv_add_f32 %1, %7, %9\n\tv_sub_f32 %4, %6, %8\n\tv_sub_f32 %5, %7, %9\n\tv_sub_f32 %2, %4, %5\n\tv_add_f32 %3, %4, %5\n\tv_mul_f32 %2, %10, %2\n\tv_mul_f32 %3, %11, %3"
                : "=&v"(px), "=&v"(py), "=&v"(qx), "=&v"(qy), "=&v"(t0), "=&v"(t1) : "v"(ax), "v"(ay), "v"(bx), "v"(by), "s"((E == 6 && !INV) ? -hx : hx), "s"(hy));
    } else { constexpr float c = E == 1 ? C1 : E == 3 ? S1 : E == 5 ? -S1 : -C1, s = (E == 1 || E == 7) ? S1 : C1;
        if (INV) asm("v_add_f32 %0, %6, %8\n\tv_add_f32 %1, %7, %9\n\tv_sub_f32 %4, %6, %8\n\tv_sub_f32 %5, %7, %9\n\tv_mul_f32 %2, %11, %5\n\tv_mul_f32 %3, %11, %4\n\tv_fma_f32 %2, %10, %4, -%2\n\tv_fma_f32 %3, %10, %5, %3"
                : "=&v"(px), "=&v"(py), "=&v"(qx), "=&v"(qy), "=&v"(t0), "=&v"(t1) : "v"(ax), "v"(ay), "v"(bx), "v"(by), "s"(c), "s"(s));
        else asm("v_add_f32 %0, %6, %8\n\tv_add_f32 %1, %7, %9\n\tv_sub_f32 %4, %6, %8\n\tv_sub_f32 %5, %7, %9\n\tv_mul_f32 %2, %11, %5\n\tv_mul_f32 %3, %11, %4\n\tv_fma_f32 %2, %10, %4, %2\n\tv_fma_f32 %3, %10, %5, -%3"
                : "=&v"(px), "=&v"(py), "=&v"(qx), "=&v"(qy), "=&v"(t0), "=&v"(t1) : "v"(ax), "v"(ay), "v"(bx), "v"(by), "s"(c), "s"(s)); }
    p = cpx{px, py}; q = cpx{qx, qy};
}
template <bool CONJ> __device__ __forceinline__ cpx cmulw(cpx a, f32x2 w) { float rx, ry;
    if (CONJ) asm("v_mul_f32 %0, %3, %5\n\tv_mul_f32 %1, %2, %5\n\tv_fma_f32 %0, %2, %4, %0\n\tv_fma_f32 %1, %3, %4, -%1" : "=&v"(rx), "=&v"(ry) : "v"(a.x), "v"(a.y), "v"(w.x), "v"(w.y));
    else asm("v_mul_f32 %0, %3, %5\n\tv_mul_f32 %1, %3, %4\n\tv_fma_f32 %0, %2, %4, -%0\n\tv_fma_f32 %1, %2, %5, %1" : "=&v"(rx), "=&v"(ry) : "v"(a.x), "v"(a.y), "v"(w.x), "v"(w.y));
    return cpx{rx, ry}; }
template <bool CONJ> __device__ __forceinline__ cpx cmulk(cpx a, float c, float s) { float rx, ry;
    if (CONJ) asm("v_mul_f32 %0, %5, %3\n\tv_mul_f32 %1, %5, %2\n\tv_fma_f32 %0, %4, %2, %0\n\tv_fma_f32 %1, %4, %3, -%1" : "=&v"(rx), "=&v"(ry) : "v"(a.x), "v"(a.y), "s"(c), "s"(s));
    else asm("v_mul_f32 %0, %5, %3\n\tv_mul_f32 %1, %5, %2\n\tv_fma_f32 %0, %4, %2, -%0\n\tv_fma_f32 %1, %4, %3, %1" : "=&v"(rx), "=&v"(ry) : "v"(a.x), "v"(a.y), "s"(c), "s"(s));
    return cpx{rx, ry}; }
template <bool INV, int H_, int ES, int BLK, int I> __device__ __forceinline__ void stage_one(cpx (&v)[16]) { bfly<(I * ES) & 7, INV>(v[BLK + I], v[BLK + I + H_]); }
template <int E> __device__ __forceinline__ cpx mulw16(cpx a) {
    constexpr float C1 = 0.92387953251f, S1 = 0.38268343236f, H = 0.70710678118f; float qx, qy, t0, t1;
    if constexpr (E == 0) return a;
    else if constexpr (E == 4) return cpx{a.y, -a.x};
    else if constexpr (E == 2) { asm("v_add_f32 %2, %4, %5\n\tv_sub_f32 %3, %5, %4\n\tv_mul_f32 %0, %6, %2\n\tv_mul_f32 %1, %6, %3" : "=&v"(qx), "=&v"(qy), "=&v"(t0), "=&v"(t1) : "v"(a.x), "v"(a.y), "s"(H)); return cpx{qx, qy}; }
    else if constexpr (E == 6) { asm("v_sub_f32 %2, %5, %4\n\tv_add_f32 %3, %4, %5\n\tv_mul_f32 %0, %6, %2\n\tv_mul_f32 %1, %7, %3" : "=&v"(qx), "=&v"(qy), "=&v"(t0), "=&v"(t1) : "v"(a.x), "v"(a.y), "s"(H), "s"(-H)); return cpx{qx, qy}; }
    else { constexpr float c = E == 1 ? C1 : E == 3 ? S1 : E == 5 ? -S1 : -C1, sn = (E == 1 || E == 7) ? S1 : C1;
        asm("v_mul_f32 %0, %5, %3\n\tv_mul_f32 %1, %5, %2\n\tv_fma_f32 %0, %4, %2, %0\n\tv_fma_f32 %1, %4, %3, -%1" : "=&v"(qx), "=&v"(qy) : "v"(a.x), "v"(a.y), "s"(c), "s"(sn)); return cpx{qx, qy}; }
}
__device__ __forceinline__ void stage8_full(cpx (&v)[16]) { stage_one<false, 8, 1, 0, 0>(v); stage_one<false, 8, 1, 0, 1>(v); stage_one<false, 8, 1, 0, 2>(v); stage_one<false, 8, 1, 0, 3>(v);
    stage_one<false, 8, 1, 0, 4>(v); stage_one<false, 8, 1, 0, 5>(v); stage_one<false, 8, 1, 0, 6>(v); stage_one<false, 8, 1, 0, 7>(v); }
__device__ __forceinline__ void stage8_zero_hi(cpx (&v)[16]) { v[8] = mulw16<0>(v[0]); v[9] = mulw16<1>(v[1]); v[10] = mulw16<2>(v[2]); v[11] = mulw16<3>(v[3]); v[12] = mulw16<4>(v[4]); v[13] = mulw16<5>(v[5]); v[14] = mulw16<6>(v[6]); v[15] = mulw16<7>(v[7]); }
template <bool INV, int PRUNE = 0> __device__ __forceinline__ void dft16(cpx (&v)[16]) {
    if constexpr (PRUNE == 3) {   }
    else if constexpr (PRUNE == 1) { static_assert(!INV, "pruned first stage: forward only");
        v[8] = mulw16<0>(v[0]); v[9] = mulw16<1>(v[1]); v[10] = mulw16<2>(v[2]); v[11] = mulw16<3>(v[3]); v[12] = mulw16<4>(v[4]); v[13] = mulw16<5>(v[5]); v[14] = mulw16<6>(v[6]); v[15] = mulw16<7>(v[7]);
    } else {
#define HF_S8(I) stage_one<INV, 8, 1, 0, I>(v)
    HF_S8(0); HF_S8(1); HF_S8(2); HF_S8(3); HF_S8(4); HF_S8(5); HF_S8(6); HF_S8(7);
#undef HF_S8
    }
#define HF_S4(B, I) stage_one<INV, 4, 2, B, I>(v)
    HF_S4(0, 0); HF_S4(0, 1); HF_S4(0, 2); HF_S4(0, 3); HF_S4(8, 0); HF_S4(8, 1); HF_S4(8, 2); HF_S4(8, 3);
#define HF_S2(B) stage_one<INV, 2, 4, B, 0>(v); stage_one<INV, 2, 4, B, 1>(v)
    HF_S2(0); HF_S2(4); HF_S2(8); HF_S2(12);
    if constexpr (PRUNE == 2) {
#pragma unroll
        for (int b = 0; b < 16; b += 2) { float px, py; asm("v_add_f32 %0, %2, %4\n\tv_add_f32 %1, %3, %5" : "=&v"(px), "=&v"(py) : "v"(v[b].x), "v"(v[b].y), "v"(v[b + 1].x), "v"(v[b + 1].y)); v[b] = cpx{px, py}; }
    } else {
#define HF_S1(B) stage_one<INV, 1, 0, B, 0>(v)
    HF_S1(0); HF_S1(2); HF_S1(4); HF_S1(6); HF_S1(8); HF_S1(10); HF_S1(12); HF_S1(14);
#undef HF_S1
    }
#undef HF_S4
#undef HF_S2
    cpx t[16];
#pragma unroll
    for (int k = 0; k < 16; ++k) t[k] = v[((k & 1) << 3) | ((k & 2) << 1) | ((k & 4) >> 1) | ((k & 8) >> 3)];
#pragma unroll
    for (int k = 0; k < 16; ++k) v[k] = t[k];
}
__device__ __forceinline__ float dppx1(float x) { return __builtin_bit_cast(float, __builtin_amdgcn_update_dpp(0, __builtin_bit_cast(int, x), 0xB1, 0xf, 0xf, true)); }
struct Ctx {
    f32x2 t1[15];
    LAS const f32x2* t2;
    int b1, b2, b3;
    float sgn; bool odd;
};
__device__ __forceinline__ void init(Ctx& c, int tid, LAS f32x2* tab) {
#pragma unroll
    for (int k = 1; k < 16; ++k) { float s, co; sincosf(-6.283185307179586f * (float)((tid * k) & (N - 1)) * (1.0f / N), &s, &co); c.t1[k - 1] = (f32x2){co, s}; }
    if (tid < 480) { const int k = 1 + (tid >> 5), b = tid & 31; float s, co; sincosf(-6.283185307179586f * (float)(16 * b * k) * (1.0f / N), &s, &co); tab[tid] = (f32x2){co, s}; }
    c.t2 = tab + (tid & 31);
    c.b1 = 8 * (tid + 2 * (tid >> 5)); c.b2 = 8 * (544 * (tid >> 5) + (tid & 31)); c.b3 = 8 * (34 * (tid >> 1) + (tid & 1));
    c.odd = tid & 1; c.sgn = c.odd ? -1.0f : 1.0f;
}
constexpr float W32[16][2] = {{1.000000000f, -0.000000000f}, {0.980785280f, -0.195090322f}, {0.923879533f, -0.382683432f}, {0.831469612f, -0.555570233f}, {0.707106781f, -0.707106781f}, {0.555570233f, -0.831469612f},
    {0.382683432f, -0.923879533f}, {0.195090322f, -0.980785280f}, {0.000000000f, -1.000000000f}, {-0.195090322f, -0.980785280f}, {-0.382683432f, -0.923879533f}, {-0.555570233f, -0.831469612f},
    {-0.707106781f, -0.707106781f}, {-0.831469612f, -0.555570233f}, {-0.923879533f, -0.382683432f}, {-0.980785280f, -0.195090322f}};
template <int STEP> __device__ __forceinline__ void xw(LAS unsigned char* buf, int base, const cpx (&v)[16]) {
#pragma unroll
    for (int j = 0; j < 16; ++j) *(LAS f32x2*)(buf + base + j * STEP) = (f32x2){v[j].x, v[j].y};
}
template <int STEP> __device__ __forceinline__ void xw1(LAS unsigned char* buf, int base, int j, const cpx& v) { *(LAS f32x2*)(buf + base + j * STEP) = (f32x2){v.x, v.y}; }
template <int STEP> __device__ __forceinline__ void xr(LAS unsigned char* buf, int base, cpx (&v)[16]) {
#pragma unroll
    for (int j = 0; j < 16; ++j) { const f32x2 t = *(LAS const f32x2*)(buf + base + j * STEP); v[j] = cpx{t.x, t.y}; }
}
__device__ __forceinline__ void fwd(cpx (&v)[16], const Ctx& c, LAS unsigned char* bufA, LAS unsigned char* bufB, bool full_in) {
    if (full_in) stage8_full(v); else stage8_zero_hi(v);
    dft16<false, 3>(v);
    { xw1<4352>(bufA, c.b1, 0, v[0]);
#pragma unroll
      for (int k = 1; k < 16; ++k) { v[k] = cmulw<false>(v[k], c.t1[k - 1]); xw1<4352>(bufA, c.b1, k, v[k]); __builtin_amdgcn_sched_barrier(0); } }
    __syncthreads(); xr<272>(bufA, c.b2, v);
    dft16<false>(v);
    { f32x2 wn = c.t2[0]; xw1<272>(bufB, c.b2, 0, v[0]);
#pragma unroll
      for (int k = 1; k < 16; ++k) { const f32x2 w = wn; if (k < 15) wn = c.t2[32 * k]; v[k] = cmulw<false>(v[k], w); xw1<272>(bufB, c.b2, k, v[k]); __builtin_amdgcn_sched_barrier(0); } }
    xr<16>(bufB, c.b3, v);
    dft16<false>(v);
    cpx o[16];
#pragma unroll
    for (int k = 0; k < 16; ++k) { const cpx t = cmulk<false>(v[k], W32[k][0], W32[k][1]); o[k] = cpx{c.odd ? t.x : v[k].x, c.odd ? t.y : v[k].y}; }
    __builtin_amdgcn_sched_barrier(0);
#pragma unroll
    for (int k = 0; k < 16; ++k) v[k] = cpx{__builtin_fmaf(c.sgn, o[k].x, dppx1(o[k].x)), __builtin_fmaf(c.sgn, o[k].y, dppx1(o[k].y))};
}
__device__ __forceinline__ void inv(cpx (&v)[16], const Ctx& c, LAS unsigned char* bufA, LAS unsigned char* bufB) {
    cpx r[16];
#pragma unroll
    for (int k = 0; k < 16; ++k) r[k] = cpx{__builtin_fmaf(c.sgn, v[k].x, dppx1(v[k].x)), __builtin_fmaf(c.sgn, v[k].y, dppx1(v[k].y))};
    __builtin_amdgcn_sched_barrier(0);
#pragma unroll
    for (int k = 0; k < 16; ++k) { const cpx t = cmulk<true>(r[k], W32[k][0], W32[k][1]); v[k] = cpx{c.odd ? t.x : r[k].x, c.odd ? t.y : r[k].y}; }
    dft16<true>(v);
    xw<16>(bufB, c.b3, v); xr<272>(bufB, c.b2, v);
    {
#pragma unroll
      for (int k = 1; k < 16; ++k) v[k] = cmulw<true>(v[k], c.t2[32 * (k - 1)]); }
    dft16<true>(v);
    xw<272>(bufA, c.b2, v); __syncthreads(); xr<4352>(bufA, c.b1, v);
    {
#pragma unroll
      for (int k = 1; k < 16; ++k) v[k] = cmulw<true>(v[k], c.t1[k - 1]); }
    dft16<true, 2>(v);
}
__device__ __forceinline__ void specmul(cpx (&v)[16], const f32x2 (&K)[16]) {
#pragma unroll
    for (int k = 0; k < 16; ++k) { const float x = v[k].x * K[k].x - v[k].y * K[k].y, y = v[k].x * K[k].y + v[k].y * K[k].x; v[k] = cpx{x, y}; }
}
}
typedef __amdgpu_buffer_rsrc_t rsrc_t;
__device__ __forceinline__ rsrc_t seq_rsrc(const bf16* p, int bytes) { return __builtin_amdgcn_make_buffer_rsrc((void*)p, 0, bytes, 0x00020000); }
namespace hfft { constexpr int ROWB = 8192 + 32; }
struct RowPair { u32x4 a, b; };
__device__ __forceinline__ RowPair rows_issue(const bf16* r0, const bf16* r1, int tid) { RowPair p; p.a = *(const u32x4*)(r0 + 8 * tid); p.b = *(const u32x4*)(r1 + 8 * tid); return p; }
__device__ __forceinline__ void rows_park(LAS unsigned char* buf, const RowPair& p, int tid) {
    *(LAS u32x4*)(buf + 16 + 16 * tid) = p.a; *(LAS u32x4*)(buf + 16 + hfft::ROWB + 16 * tid) = p.b;
    if (tid < 2) { *(LAS unsigned*)(buf + 12 + tid * hfft::ROWB) = 0u; *(LAS unsigned*)(buf + 16 + 8192 + tid * hfft::ROWB) = 0u; }
}
__device__ __forceinline__ float rows_rd(LAS const unsigned char* p, int off) { return bf2f(*(LAS const unsigned short*)(p + off)); }
__device__ __forceinline__ float rows_sconv(LAS const unsigned char* p, int off, float w0, float w1, float w2, float cb) {
    const unsigned r0 = *(LAS const unsigned short*)(p + off), r1 = *(LAS const unsigned short*)(p + off + 2), r2 = *(LAS const unsigned short*)(p + off + 4);
    float y, t0, t1, t2;
    asm("v_lshlrev_b32 %1, 16, %4\n\tv_lshlrev_b32 %2, 16, %5\n\tv_lshlrev_b32 %3, 16, %6\n\tv_fma_f32 %0, %7, %1, %10\n\tv_fma_f32 %0, %8, %2, %0\n\tv_fma_f32 %0, %9, %3, %0"
        : "=&v"(y), "=&v"(t0), "=&v"(t1), "=&v"(t2) : "v"(r0), "v"(r1), "v"(r2), "s"(w0), "s"(w1), "s"(w2), "v"(cb));
    return y; }
__device__ __forceinline__ void hyena_fft(const Args& args, Frame& F, bool dry = false) {
    using namespace hfft;
    LAS unsigned char* bufA = F.lds; LAS unsigned char* bufB = F.lds + BUFB; LAS unsigned char* bufG = F.lds + 2 * BUFB;
    const float* cw = args.in[I_CW]; const float* cbv = args.in[I_CB];
    const int tid = F.tid;
    Ctx cx; init(cx, tid, (LAS f32x2*)(F.lds + 2 * BUFB + 16464)); __syncthreads();
    f32x2* KS = WSP(f32x2, WS_KS) + (size_t)F.bid * N;
    const bf16* TAP = WSP(bf16, WS_TAPL);
    RowPair pin, pg;
    { const int c0 = F.bid < 1024 ? F.bid : 0; pin = rows_issue(TAP + (size_t)c0 * 8192, TAP + (size_t)(1024 + c0) * 8192, tid); pg = rows_issue(TAP + (size_t)c0 * 8192 + 4096, TAP + (size_t)(1024 + c0) * 8192 + 4096, tid); }
#pragma unroll 1
    for (int c = F.bid; c < 1024; c += F.G) {
        bf16* r1 = WSP(bf16, WS_HYT) + NCTX + (size_t)c * MTOK; const bf16* r2 = r1 + (size_t)1024 * MTOK; bf16* r3 = r1 + (size_t)2048 * MTOK;
        const int cn = c + F.G < 1024 ? c + F.G : c;
        f32x2 K[16];
#pragma unroll 1
        for (int job = 0; job < 9; ++job) {
            const int sweep = job >= 5, bp = (job - 1) & 3;
            const size_t o0 = (size_t)(2 * bp) * LSEQ, o1 = o0 + LSEQ;
            if (job != 0) pg = sweep ? rows_issue(r2 + o0, r2 + o1, tid) : rows_issue(r1 + o0, r1 + o1, tid);
            const int cg = sweep * 1024 + c;
            const float wg0 = cw[cg], wg1 = cw[NHY + cg], wg2 = cw[2 * NHY + cg], bg = cbv[cg];
            rows_park(bufB, pin, tid);
            if (job == 0) rows_park(bufG, pg, tid);
            __syncthreads();
            { const int jn = job + 1;
              if (jn < 9) { const size_t on = (size_t)(2 * ((jn - 1) & 3)) * LSEQ; pin = rows_issue(r3 + on, r3 + on + LSEQ, tid); }
              else pin = rows_issue(TAP + (size_t)cn * 8192, TAP + (size_t)(1024 + cn) * 8192, tid); }
            int t2 = 2 * tid; asm volatile("" : "+v"(t2));
            LAS const unsigned char* pB = bufB + 14 + t2; LAS const unsigned char* pG = bufG + 14 + t2;
            cpx d[16];
            if (job == 0) {
                const float* p0 = WSP(float, WS_INVS) + (size_t)c * 2; const float* p1 = WSP(float, WS_INVS) + (size_t)(1024 + c) * 2;
                const float i0 = 1.0f / (p0[0] + p0[1] + EPSF), i1 = 1.0f / (p1[0] + p1[1] + EPSF), sk0 = args.in[I_HSKIP][c], sk1 = args.in[I_HSKIP][1024 + c];
                LAS const unsigned char* qB = bufB + 16 + 2 * (4095 - 3584) - t2; LAS const unsigned char* qG = bufG + 16 + 2 * (4095 - 3584) - t2;
#pragma unroll
                for (int j = 0; j < 16; ++j) { const int jj = j & 7; LAS const unsigned char* q = j < 8 ? qB : qG;
                    d[j] = cpx{rows_rd(q, 1024 * (7 - jj)) * i0, rows_rd(q, ROWB + 1024 * (7 - jj)) * i1};
                    if (j == 0 && tid == 0) { d[j].x += sk0; d[j].y += sk1; } }
            } else if (!sweep) {
                const float wv0 = cw[2048 + c], wv1 = cw[NHY + 2048 + c], wv2 = cw[2 * NHY + 2048 + c], bv = cbv[2048 + c];
#pragma unroll
                for (int j = 0; j < 8; ++j) { d[j] = cpx{rows_sconv(pB, 1024 * j, wv0, wv1, wv2, bv), rows_sconv(pB, ROWB + 1024 * j, wv0, wv1, wv2, bv)}; d[j + 8] = cpx{0.f, 0.f}; }
            } else {
#pragma unroll
                for (int j = 0; j < 8; ++j) { d[j] = cpx{rows_rd(pB, 1024 * j + 2), rows_rd(pB, ROWB + 1024 * j + 2)}; d[j + 8] = cpx{0.f, 0.f}; }
            }
            fwd(d, cx, bufA, bufB, job == 0);
            if (job == 0) {
                LAS f32x2* xb = (LAS f32x2*)bufA;
                __syncthreads();
#pragma unroll
                for (int k = 0; k < 16; ++k) xb[k * 512 + tid] = (f32x2){d[k].x, d[k].y};
                __syncthreads();
                const int fbase = (tid >> 5) + 16 * ((tid >> 1) & 15) + 4096 * (tid & 1); const float sc = 0.5f / (float)N;
#pragma unroll
                for (int k = 0; k < 16; ++k) { const int f = fbase + 256 * k, fp = (N - f) & (N - 1), tp = 32 * (fp & 15) + 2 * ((fp >> 4) & 15) + (fp >> 12), kp = (fp >> 8) & 15;
                    const f32x2 xp = xb[kp * 512 + tp];
                    K[k] = (f32x2){(d[k].x + xp.x) * sc, (d[k].y - xp.y) * sc};
                    KS[k * 512 + tid] = (f32x2){(d[k].y + xp.y) * sc, (xp.x - d[k].x) * sc}; }
            } else {
                specmul(d, K);
                if (job == 4) {
#pragma unroll
                    for (int k = 0; k < 16; ++k) K[k] = KS[k * 512 + tid]; }
                rows_park(bufG, pg, tid);
                if (job == 8) pg = rows_issue(TAP + (size_t)cn * 8192 + 4096, TAP + (size_t)(1024 + cn) * 8192 + 4096, tid);
                inv(d, cx, bufA, bufB);
                const rsrc_t q0 = seq_rsrc((sweep ? r1 : r3) + o0, 8192), q1 = seq_rsrc((sweep ? r1 : r3) + o1, 8192);
#pragma unroll
                for (int j = 0; j < 8; ++j) { const int t = tid + 512 * j;
                    const float y0 = rows_sconv(pG, 1024 * j, wg0, wg1, wg2, bg) * d[j].x;
                    const float y1 = rows_sconv(pG, ROWB + 1024 * j, wg0, wg1, wg2, bg) * d[j].y;
                    unsigned yp; asm("v_cvt_pk_bf16_f32 %0, %1, %2" : "=v"(yp) : "v"(y0), "v"(y1));
                    if (!dry) { __builtin_amdgcn_raw_buffer_store_b16((short)(yp & 0xffffu), q0, 2 * t, 0, 0); __builtin_amdgcn_raw_buffer_store_b16((short)(yp >> 16), q1, 2 * t, 0, 0); } }
            }
        }
        __syncthreads();
    }
}
__device__ __forceinline__ void hy_transpose(const Args& args, Frame& F) {
    LAS unsigned char* tile = F.lds + F.wave * 8192;
    const int h0 = F.G / 2; if (F.bid < h0) return;
    const int gw = (F.bid - h0) * NWAVES + F.wave, NGW = (F.G - h0) * NWAVES, lane = F.lane, ch8 = lane & 7, rq = lane >> 3;
    const bf16* src = WSP(bf16, WS_HYT); bf16* dst = WSP(bf16, WS_HYO);
    for (int it = gw; it < (1024 / 64) * (MTOK / 64); it += NGW) {
        const int cb = it % 16, mb = it / 16;
        u32x4 v[8];
#pragma unroll
        for (int i = 0; i < 8; ++i) v[i] = *(const u32x4*)(src + (size_t)(cb * 64 + rq + 8 * i) * MTOK + mb * 64 + ch8 * 8);
#pragma unroll
        for (int i = 0; i < 8; ++i) *(LAS u32x4*)(tile + (rq + 8 * i) * 128 + ((ch8 ^ i) * 16)) = v[i];
        LDS_WAIT(); asm volatile("" ::: "memory");
#pragma unroll
        for (int i = 0; i < 8; ++i) { const int tok = rq + 8 * i;
            unsigned short e[8];
#pragma unroll
            for (int j = 0; j < 8; ++j) e[j] = *(LAS const unsigned short*)(tile + (ch8 * 8 + j) * 128 + ((i ^ ch8) * 16) + (tok & 7) * 2);
            u32x4 o; o.x = e[0] | ((unsigned)e[1] << 16); o.y = e[2] | ((unsigned)e[3] << 16); o.z = e[4] | ((unsigned)e[5] << 16); o.w = e[6] | ((unsigned)e[7] << 16);
            *(u32x4*)(dst + (size_t)(mb * 64 + tok) * DM + cb * 64 + ch8 * 8) = o; }
        LDS_WAIT(); asm volatile("" ::: "memory");
    }
}
struct EpiGates { bf16* GA; bf16* GH; __device__ __forceinline__ void operator()(int row, int col, float v, float) const {
    const unsigned s = f2bf(sigmoidf_(v)); if (col < DM) GA[(size_t)row * DM + col] = (bf16)s; else GH[(size_t)row * DM + col - DM] = (bf16)s; } };
struct EpiMA { const bf16* GA; bf16* MA; __device__ __forceinline__ void operator()(int row, int col, float v, float) const { MA[(size_t)row * DM + col] = (bf16)f2bf(bf2f(GA[(size_t)row * DM + col]) * v); } };
struct EpiMerged { const bf16* GH; const bf16* MA; bf16* O; __device__ __forceinline__ void operator()(int row, int col, float v, float) const {
    O[(size_t)row * DM + col] = (bf16)f2bf(bf2f(MA[(size_t)row * DM + col]) + bf2f(GH[(size_t)row * DM + col]) * v); } };

namespace pg8 {
#define PG8_LAS __attribute__((address_space(3)))
typedef unsigned short bf16_t;
typedef short bf16x8 __attribute__((ext_vector_type(8)));
typedef float f32x4 __attribute__((ext_vector_type(4)));
typedef unsigned u32x4 __attribute__((ext_vector_type(4)));
constexpr int BM = 256, BK = 64, HALF = 128, HTB = HALF * BK * 2  , STAGE_BYTES = 8 * HTB, NXCD = 8, WGM = 8;
__host__ __device__ __forceinline__ int lds_byte(int r, int c) { const int st = (r >> 4) * 2 + (c >> 5), rr = r & 15, cc = c & 31, ob = rr * 64 + cc * 2; return st * 1024 + (ob ^ (((ob >> 9) & 1) << 5)); }
__host__ __device__ __forceinline__ void stage_rc(int b, int& R, int& C) { const int st = b / 1024, sb = b % 1024, swz = sb ^ (((sb >> 9) & 1) << 5); R = (st >> 1) * 16 + swz / 64; C = (st & 1) * 32 + (swz % 64) / 2; }
__host__ __device__ __forceinline__ int perm32(int rho) { const int n = rho >> 4, i = rho & 15; return 8 * (i >> 2) + 4 * n + (i & 3); }
struct Unit { int pm, pn; };
struct Gemm { const bf16_t* A; const bf16_t* Bt; int M, N, K; };
struct StaticOrder {
    int nM, nN, nwg, G, c;
    __host__ __device__ void init(int M, int N, int G_, int c_, int TM = BM) { nM = M / TM; nN = N / BM; nwg = nM * nN; G = G_; c = c_; }
    __host__ __device__ bool next(int i, Unit& u) const {
        const long L = (long)i * G + c; if (L >= nwg) return false;
        int wgid = (int)L; { const int q = nwg / NXCD, r = nwg % NXCD, xcd = wgid % NXCD, off = wgid / NXCD; wgid = (xcd < r ? xcd * (q + 1) : r * (q + 1) + (xcd - r) * q) + off; }
        const int nig = WGM * nN, gid = wgid / nig, fm = gid * WGM, gsz = (nM - fm) < WGM ? (nM - fm) : WGM;
        u.pm = fm + ((wgid % nig) % gsz); u.pn = (wgid % nig) / gsz; return true;
    }
    __device__ __forceinline__ void a_ready(const Unit&) const {}
    __device__ __forceinline__ void done(const Unit&) const {}
};
typedef float f32x2_t __attribute__((ext_vector_type(2))); typedef __bf16 bf16x2_t __attribute__((ext_vector_type(2)));
__device__ __forceinline__ unsigned cvt_pk_bf16(float lo, float hi) { f32x2_t v = {lo, hi}; bf16x2_t b = __builtin_convertvector(v, bf16x2_t); return __builtin_bit_cast(unsigned, b); }
template <class Epi, class Sched, bool ALIGN_EPI = false, bool SP2 = false, int MF = 4>
__device__ __forceinline__ void gemm_phase(PG8_LAS unsigned char* lds, const Gemm g, const Sched& S, const Epi& E) {
    const int tid = threadIdx.x, wid = __builtin_amdgcn_readfirstlane(tid >> 6), lane = tid & 63, wr = wid >> 2, wc = wid & 3, fr = lane & 15, fq = lane >> 4;
    const int K = g.K, nt = K / BK;
    unsigned voffA[2], voffB[2];
#pragma unroll
    for (int i = 0; i < 2; ++i) { int R, C; stage_rc(tid * 16 + i * 8192, R, C); const int Rb = Epi::PERM ? ((R & ~31) + perm32(R & 31)) : R;
        voffA[i] = (unsigned)(R * K + C) * 2u; voffB[i] = (unsigned)(Rb * K + C) * 2u; }
    const size_t kstep = (size_t)(BK * 2);
    const size_t hstepA = (size_t)(32 * MF) * K * 2, hstepB = (size_t)HALF * K * 2;
    const size_t tstepA = 2 * hstepA, tstepB = 2 * hstepB;
    const unsigned ldsw = (unsigned)wid * 1024u;
    const int aoff = lds_byte(wr * (16 * MF) + fr, fq * 8), boff = lds_byte(wc * 32 + fr, fq * 8);
#define PG8_SA(b, h) (((b) * 2 + (h)) * HTB)
#define PG8_SB(b, h) ((4 + (b) * 2 + (h)) * HTB)
#define PG8_STAGE(bufoff, gbase, voff) do { _Pragma("unroll") for (int _i = 0; _i < 2; ++_i) \
        __builtin_amdgcn_global_load_lds((const unsigned*)((const char*)(gbase) + (voff)[_i]), (PG8_LAS unsigned*)(lds + (bufoff) + ldsw + _i * 8192), 16, 0, 0); } while (0)
#define PG8_LDA(dst, b, h) do { _Pragma("unroll") for (int m = 0; m < MF; ++m) _Pragma("unroll") for (int k = 0; k < 2; ++k) dst[m][k] = *(const PG8_LAS bf16x8*)(lds + PG8_SA(b, h) + aoff + m * 2048 + k * 1024); } while (0)
#define PG8_LDB(dst, b, h) do { _Pragma("unroll") for (int n = 0; n < 2; ++n) _Pragma("unroll") for (int k = 0; k < 2; ++k) dst[n][k] = *(const PG8_LAS bf16x8*)(lds + PG8_SB(b, h) + boff + n * 2048 + k * 1024); } while (0)
#define PG8_MMA(ai, bj, At, Bt) do { __builtin_amdgcn_s_setprio(1); _Pragma("unroll") for (int m = 0; m < MF; ++m) _Pragma("unroll") for (int n = 0; n < 2; ++n) _Pragma("unroll") for (int k = 0; k < 2; ++k) \
        acc[ai][bj][m][n] = __builtin_amdgcn_mfma_f32_16x16x32_bf16(Bt[n][k], At[m][k], acc[ai][bj][m][n], 0, 0, 0); __builtin_amdgcn_s_setprio(0); } while (0)
#define PG8_WAIT_V(n) asm volatile("s_waitcnt vmcnt(" #n ")" ::: "memory")
#define PG8_WAIT_L(n) asm volatile("s_waitcnt lgkmcnt(" #n ")" ::: "memory")
#define PG8_BAR __builtin_amdgcn_s_barrier()
#define PG8_SCHED __builtin_amdgcn_sched_barrier(0)
    Unit cur, nxt; int ui = 0;
    if (!S.next(0, cur)) return;
    f32x4 acc[2][2][MF][2];
#pragma unroll
    for (int a = 0; a < 2; ++a)
#pragma unroll
        for (int b = 0; b < 2; ++b)
#pragma unroll
            for (int m = 0; m < MF; ++m)
#pragma unroll
                for (int n = 0; n < 2; ++n) acc[a][b][m][n] = (f32x4){0.f, 0.f, 0.f, 0.f};
    bf16x8 At[MF][2], B0[2][2], B1[2][2];
    const char* cA = (const char*)g.A + (size_t)cur.pm * tstepA; const char* cB = (const char*)g.Bt + (size_t)cur.pn * tstepB;
    S.a_ready(cur);
    if constexpr (SP2) {
        PG8_STAGE(PG8_SB(0, 0), cB, voffB); PG8_STAGE(PG8_SB(0, 1), cB + hstepB, voffB); PG8_STAGE(PG8_SA(0, 0), cA, voffA); PG8_STAGE(PG8_SA(0, 1), cA + hstepA, voffA);
        if (wr == 1) PG8_BAR;
        PG8_WAIT_V(2); PG8_BAR;
        PG8_STAGE(PG8_SB(1, 0), cB + kstep, voffB); PG8_STAGE(PG8_SA(1, 0), cA + kstep, voffA); PG8_STAGE(PG8_SB(1, 1), cB + hstepB + kstep, voffB);
        PG8_WAIT_V(6); PG8_BAR;
    } else {
        PG8_STAGE(PG8_SB(0, 0), cB, voffB); PG8_STAGE(PG8_SA(0, 0), cA, voffA); PG8_STAGE(PG8_SB(0, 1), cB + hstepB, voffB); PG8_STAGE(PG8_SA(0, 1), cA + hstepA, voffA);
        if (wr == 1) PG8_BAR;
        PG8_WAIT_V(4); PG8_BAR;
        PG8_STAGE(PG8_SB(1, 0), cB + kstep, voffB); PG8_STAGE(PG8_SA(1, 0), cA + kstep, voffA); PG8_STAGE(PG8_SB(1, 1), cB + hstepB + kstep, voffB);
        PG8_WAIT_V(6); PG8_BAR;
    }
    for (;;) {
        const bool has_next = S.next(ui + 1, nxt);
        const char* nA = has_next ? (const char*)g.A + (size_t)nxt.pm * tstepA : cA; const char* nB = has_next ? (const char*)g.Bt + (size_t)nxt.pn * tstepB : cB;
        for (int t = 0; t < nt; t += 2) {
            const bool last = (t == nt - 2);
            const char* a1 = cA + (size_t)(t + 1) * kstep;
            const char* a2 = last ? nA : cA + (size_t)(t + 2) * kstep; const char* b2 = last ? nB : cB + (size_t)(t + 2) * kstep;
            const char* a3 = a2 + kstep; const char* b3 = b2 + kstep;
            if (last && has_next) S.a_ready(nxt);
            if constexpr (SP2) {
            PG8_LDB(B0, 0, 0); PG8_LDB(B1, 0, 1); PG8_SCHED; PG8_LDA(At, 0, 0); PG8_STAGE(PG8_SA(1, 1), a1 + hstepA, voffA);
            PG8_WAIT_V(8); PG8_WAIT_L(0); PG8_BAR; PG8_MMA(0, 0, At, B0); PG8_MMA(0, 1, At, B1); PG8_BAR; PG8_SCHED;
            PG8_LDA(At, 0, 1); PG8_STAGE(PG8_SB(0, 0), b2, voffB); PG8_STAGE(PG8_SB(0, 1), b2 + hstepB, voffB); PG8_STAGE(PG8_SA(0, 0), a2, voffA);
            PG8_WAIT_V(8); PG8_WAIT_L(0); PG8_BAR; PG8_MMA(1, 0, At, B0); PG8_MMA(1, 1, At, B1); PG8_BAR; PG8_SCHED;
            PG8_LDB(B0, 1, 0); PG8_LDB(B1, 1, 1); PG8_SCHED; PG8_LDA(At, 1, 0); PG8_STAGE(PG8_SA(0, 1), a2 + hstepA, voffA);
            PG8_WAIT_V(8); PG8_WAIT_L(0); PG8_BAR; PG8_MMA(0, 0, At, B0); PG8_MMA(0, 1, At, B1); PG8_BAR; PG8_SCHED;
            PG8_LDA(At, 1, 1); PG8_STAGE(PG8_SB(1, 0), b3, voffB); PG8_STAGE(PG8_SB(1, 1), b3 + hstepB, voffB); PG8_STAGE(PG8_SA(1, 0), a3, voffA);
            PG8_WAIT_V(8); PG8_WAIT_L(0); PG8_BAR; PG8_MMA(1, 0, At, B0); PG8_MMA(1, 1, At, B1); PG8_BAR; PG8_SCHED;
            } else {
            PG8_LDB(B0, 0, 0); PG8_SCHED; PG8_LDA(At, 0, 0); PG8_STAGE(PG8_SA(1, 1), a1 + hstepA, voffA);
            PG8_WAIT_L(8); PG8_BAR; PG8_WAIT_L(0); PG8_MMA(0, 0, At, B0); PG8_BAR; PG8_SCHED;
            PG8_LDB(B1, 0, 1); PG8_STAGE(PG8_SB(0, 0), b2, voffB);
            PG8_BAR; PG8_WAIT_L(0); PG8_MMA(0, 1, At, B1); PG8_BAR;
            PG8_LDA(At, 0, 1); PG8_STAGE(PG8_SA(0, 0), a2, voffA);
            PG8_BAR; PG8_WAIT_L(0); PG8_MMA(1, 0, At, B0); PG8_BAR; PG8_SCHED;
            PG8_STAGE(PG8_SB(0, 1), b2 + hstepB, voffB);
            PG8_WAIT_V(6); PG8_BAR; PG8_MMA(1, 1, At, B1); PG8_BAR;
            PG8_LDB(B0, 1, 0); PG8_SCHED; PG8_LDA(At, 1, 0); PG8_STAGE(PG8_SA(0, 1), a2 + hstepA, voffA);
            PG8_WAIT_L(8); PG8_BAR; PG8_WAIT_L(0); PG8_MMA(0, 0, At, B0); PG8_BAR; PG8_SCHED;
            PG8_LDB(B1, 1, 1); PG8_STAGE(PG8_SB(1, 0), b3, voffB);
            PG8_BAR; PG8_WAIT_L(0); PG8_MMA(0, 1, At, B1); PG8_BAR;
            PG8_LDA(At, 1, 1); PG8_STAGE(PG8_SA(1, 0), a3, voffA);
            PG8_BAR; PG8_WAIT_L(0); PG8_MMA(1, 0, At, B0); PG8_BAR; PG8_SCHED;
            PG8_STAGE(PG8_SB(1, 1), b3 + hstepB, voffB);
            PG8_WAIT_V(6); PG8_BAR; PG8_MMA(1, 1, At, B1); PG8_BAR;
            }
        }
        if constexpr (ALIGN_EPI) { if (wr == 0) PG8_BAR; }
        if constexpr (!Epi::AFTER_DRAIN) { E(acc, cur, wr, wc, fr, fq); S.done(cur); }
        if (!has_next) break;
#pragma unroll
        for (int a = 0; a < 2; ++a)
#pragma unroll
            for (int b = 0; b < 2; ++b)
#pragma unroll
                for (int m = 0; m < MF; ++m)
#pragma unroll
                    for (int n = 0; n < 2; ++n) acc[a][b][m][n] = (f32x4){0.f, 0.f, 0.f, 0.f};
        cur = nxt; cA = nA; cB = nB; ++ui;
        if constexpr (ALIGN_EPI) { if (wr == 1) PG8_BAR; }
    }
    PG8_WAIT_V(0);
    if constexpr (!ALIGN_EPI) { if (wr == 0) PG8_BAR; }
    PG8_BAR;
    if constexpr (Epi::AFTER_DRAIN) { E.fused(acc, cur, wr, wc, fr, fq, lds, wid, lane); S.done(cur); }
#undef PG8_SA
#undef PG8_SB
#undef PG8_STAGE
#undef PG8_LDA
#undef PG8_LDB
#undef PG8_MMA
#undef PG8_WAIT_V
#undef PG8_WAIT_L
#undef PG8_BAR
#undef PG8_SCHED
}
}

namespace pg8 {
typedef unsigned u32x2 __attribute__((ext_vector_type(2)));
__device__ __forceinline__ float silu_f(float g) { return g * __builtin_amdgcn_rcpf(1.0f + __expf(-g)); }
__device__ __forceinline__ float sigm_f(float g) { return __builtin_amdgcn_rcpf(1.0f + __expf(-g)); }
__device__ __forceinline__ float bflo(unsigned w) { return __builtin_bit_cast(float, w << 16); }
__device__ __forceinline__ float bfhi(unsigned w) { return __builtin_bit_cast(float, w & 0xffff0000u); }
struct EpiBf16P { static constexpr bool PERM = true, AFTER_DRAIN = false; bf16_t* O; int ldc;
    __device__ __forceinline__ void operator()(const f32x4 (&acc)[2][2][4][2], const Unit& u, int wr, int wc, int fr, int fq) const {
        const int row0 = u.pm * BM + wr * 64 + fr, col0 = u.pn * BM + wc * 32 + 8 * fq;
#pragma unroll
        for (int ai = 0; ai < 2; ++ai)
#pragma unroll
            for (int m = 0; m < 4; ++m) { bf16_t* rowp = O + (size_t)(row0 + ai * HALF + m * 16) * ldc + col0;
#pragma unroll
                for (int bj = 0; bj < 2; ++bj) { const f32x4 v0 = acc[ai][bj][m][0], v1 = acc[ai][bj][m][1];
                    u32x4 w; w.x = cvt_pk_bf16(v0[0], v0[1]); w.y = cvt_pk_bf16(v0[2], v0[3]); w.z = cvt_pk_bf16(v1[0], v1[1]); w.w = cvt_pk_bf16(v1[2], v1[3]);
                    *(u32x4*)(rowp + bj * HALF) = w; } }
    }
};
struct EpiSwigluF { static constexpr bool PERM = true, AFTER_DRAIN = false; bf16_t* U;
    __device__ __forceinline__ void operator()(const f32x4 (&acc)[2][2][4][2], const Unit& u, int wr, int wc, int fr, int fq) const {
        const int row0 = u.pm * BM + wr * 64 + fr, col0 = u.pn * HALF + wc * 32 + 8 * fq;
#pragma unroll
        for (int ai = 0; ai < 2; ++ai)
#pragma unroll
            for (int m = 0; m < 4; ++m) { bf16_t* rowp = U + (size_t)(row0 + ai * HALF + m * 16) * DFF + col0;
                const f32x4 g0 = acc[ai][0][m][0], g1 = acc[ai][0][m][1], u0 = acc[ai][1][m][0], u1 = acc[ai][1][m][1];
                u32x4 w; w.x = cvt_pk_bf16(silu_f(g0[0]) * u0[0], silu_f(g0[1]) * u0[1]); w.y = cvt_pk_bf16(silu_f(g0[2]) * u0[2], silu_f(g0[3]) * u0[3]);
                w.z = cvt_pk_bf16(silu_f(g1[0]) * u1[0], silu_f(g1[1]) * u1[1]); w.w = cvt_pk_bf16(silu_f(g1[2]) * u1[2], silu_f(g1[3]) * u1[3]);
                *(u32x4*)rowp = w; }
    }
};
template <bool FROM_IN> struct EpiResF { static constexpr bool PERM = false, AFTER_DRAIN = false;
    const float* xp; const float* xs; float* out; const float* mod; int goff; float coef;
    __device__ __forceinline__ void operator()(const f32x4 (&acc)[2][2][4][2], const Unit& u, int wr, int wc, int fr, int fq) const {
        const int row0 = u.pm * BM + wr * 64 + fr, col0 = u.pn * BM + wc * 32 + 4 * fq;
        const float* g = mod + mod_row(u.pm * BM) * MODW + goff + col0;
        f32x4 gv[2][2];
#pragma unroll
        for (int bj = 0; bj < 2; ++bj)
#pragma unroll
            for (int n = 0; n < 2; ++n) gv[bj][n] = *(const f32x4*)(g + bj * HALF + n * 16) * coef;
        const float* src = FROM_IN ? (u.pm * BM < NCTX ? xp + (size_t)row0 * DM : xs + (size_t)(row0 - NCTX) * DM) : out + (size_t)row0 * DM;
        float* dst = out + (size_t)row0 * DM;
#pragma unroll
        for (int ai = 0; ai < 2; ++ai)
#pragma unroll
            for (int m = 0; m < 4; ++m) { const size_t ro = (size_t)(ai * HALF + m * 16) * DM + col0;
#pragma unroll
                for (int bj = 0; bj < 2; ++bj)
#pragma unroll
                    for (int n = 0; n < 2; ++n) { const f32x4 x = *(const f32x4*)(src + ro + bj * HALF + n * 16); *(f32x4*)(dst + ro + bj * HALF + n * 16) = x + gv[bj][n] * acc[ai][bj][m][n]; }
                asm volatile("" ::: "memory"); }
    }
};
template <bool FROM_IN> struct EpiResF3 { static constexpr bool PERM = false, AFTER_DRAIN = false;
    const float* xp; const float* xs; float* out; const float* mod; int goff; float coef;
    __device__ __forceinline__ void operator()(const f32x4 (&acc)[2][2][3][2], const Unit& u, int wr, int wc, int fr, int fq) const {
        const int row0 = u.pm * 192 + wr * 48 + fr, col0 = u.pn * BM + wc * 32 + 4 * fq;
#pragma unroll
        for (int ai = 0; ai < 2; ++ai)
#pragma unroll
            for (int m = 0; m < 3; ++m) { const int row = row0 + ai * 96 + m * 16;
                const float* g = mod + mod_row(row) * MODW + goff + col0;
                const float* src = (FROM_IN ? (row < NCTX ? xp + (size_t)row * DM : xs + (size_t)(row - NCTX) * DM) : out + (size_t)row * DM) + col0;
                float* dst = out + (size_t)row * DM + col0;
#pragma unroll
                for (int bj = 0; bj < 2; ++bj)
#pragma unroll
                    for (int n = 0; n < 2; ++n) { const f32x4 gv = *(const f32x4*)(g + bj * HALF + n * 16) * coef, x = *(const f32x4*)(src + bj * HALF + n * 16);
                        *(f32x4*)(dst + bj * HALF + n * 16) = x + gv * acc[ai][bj][m][n]; }
                asm volatile("" ::: "memory"); }
    }
};
template <int SRC, bool DSTF> struct EpiResB3 { static constexpr bool PERM = true, AFTER_DRAIN = false;
    const float* xp; const float* xs; const bf16_t* xb; bf16_t* ob; float* of; const float* mod; int goff; float coef;
    __device__ __forceinline__ void operator()(const f32x4 (&acc)[2][2][3][2], const Unit& u, int wr, int wc, int fr, int fq) const {
        const int row0 = u.pm * 192 + wr * 48 + fr, col0 = u.pn * BM + wc * 32 + 8 * fq;
#pragma unroll
        for (int ai = 0; ai < 2; ++ai)
#pragma unroll
            for (int m = 0; m < 3; ++m) { const int row = row0 + ai * 96 + m * 16;
                const float* g = mod + mod_row(row) * MODW + goff + col0;
                const size_t ro = (size_t)row * DM + col0;
                const float* srcf = (row < NCTX ? xp + (size_t)row * DM : xs + (size_t)(row - NCTX) * DM) + col0;
#pragma unroll
                for (int bj = 0; bj < 2; ++bj) {
                    const f32x4 g0 = *(const f32x4*)(g + bj * HALF) * coef, g1 = *(const f32x4*)(g + bj * HALF + 4) * coef;
                    f32x4 x0, x1;
                    if (SRC == 0) { x0 = *(const f32x4*)(srcf + bj * HALF); x1 = *(const f32x4*)(srcf + bj * HALF + 4); }
                    else { const u32x4 p = *(const u32x4*)(xb + ro + bj * HALF); x0 = (f32x4){bflo(p.x), bfhi(p.x), bflo(p.y), bfhi(p.y)}; x1 = (f32x4){bflo(p.z), bfhi(p.z), bflo(p.w), bfhi(p.w)}; }
                    const f32x4 y0 = x0 + g0 * acc[ai][bj][m][0], y1 = x1 + g1 * acc[ai][bj][m][1];
                    if (DSTF) { *(f32x4*)(of + ro + bj * HALF) = y0; *(f32x4*)(of + ro + bj * HALF + 4) = y1; }
                    else { u32x4 w; w.x = cvt_pk_bf16(y0[0], y0[1]); w.y = cvt_pk_bf16(y0[2], y0[3]); w.z = cvt_pk_bf16(y1[0], y1[1]); w.w = cvt_pk_bf16(y1[2], y1[3]); *(u32x4*)(ob + ro + bj * HALF) = w; } }
                asm volatile("" ::: "memory"); }
    }
};
struct EpiQKVF { static constexpr bool PERM = false, AFTER_DRAIN = false;
    bf16_t *Q, *KC, *KL, *VC, *VL; float* nk; float* nv; const float* qn; const float* kn; const float* rope;
    __device__ __forceinline__ void operator()(const f32x4 (&acc)[2][2][4][2], const Unit& u, int wr, int wc, int fr, int fq) const {
        const int row0 = u.pm * BM + wr * 64 + fr; const bool lat = u.pm * BM >= NCTX;
        if (u.pn == 5) {
#pragma unroll
            for (int ai = 0; ai < 2; ++ai)
#pragma unroll
                for (int m = 0; m < 4; ++m) { const int row = row0 + ai * HALF + m * 16, t = (row - NCTX) & (LSEQ - 1), bl = (row - NCTX) >> 12;
                    bf16_t* dst = (lat ? VL + ((size_t)bl * KLROWS + PAST + t) * KVW : VC + (size_t)row * KVW) + wc * 32 + 4 * fq;
#pragma unroll
                    for (int bj = 0; bj < 2; ++bj)
#pragma unroll
                        for (int n = 0; n < 2; ++n) { const f32x4 v = acc[ai][bj][m][n]; u32x2 w; w.x = cvt_pk_bf16(v[0], v[1]); w.y = cvt_pk_bf16(v[2], v[3]);
                            *(u32x2*)(dst + bj * HALF + n * 16) = w;
                            if (!lat) *(f32x4*)(nv + (size_t)row * KVW + wc * 32 + 4 * fq + bj * HALF + n * 16) = v; } }
            return;
        }
        const bool isq = u.pn < 4; const float* nw = isq ? qn : kn;
        f32x4 w4[2][2];
#pragma unroll
        for (int bj = 0; bj < 2; ++bj)
#pragma unroll
            for (int n = 0; n < 2; ++n) w4[bj][n] = *(const f32x4*)(nw + 32 * bj + 16 * n + 4 * fq);
#pragma unroll
        for (int ai = 0; ai < 2; ++ai)
#pragma unroll
            for (int m = 0; m < 4; ++m) { const int row = row0 + ai * HALF + m * 16, t = (row - NCTX) & (LSEQ - 1), bl = (row - NCTX) >> 12;
                f32x4 v[2][2]; float ss = 0.f;
#pragma unroll
                for (int bj = 0; bj < 2; ++bj)
#pragma unroll
                    for (int n = 0; n < 2; ++n) { v[bj][n] = acc[ai][bj][m][n]; ss += (v[bj][n][0] * v[bj][n][0] + v[bj][n][1] * v[bj][n][1]) + (v[bj][n][2] * v[bj][n][2] + v[bj][n][3] * v[bj][n][3]); }
                ss += __shfl_xor(ss, 16); ss += __shfl_xor(ss, 32);
                const float rs = 1.0f / sqrtf(ss * (1.0f / 64.0f) + EPSF);
#pragma unroll
                for (int bj = 0; bj < 2; ++bj)
#pragma unroll
                    for (int n = 0; n < 2; ++n) v[bj][n] = v[bj][n] * rs * w4[bj][n];
                if (!isq && !lat) {
#pragma unroll
                    for (int bj = 0; bj < 2; ++bj)
#pragma unroll
                        for (int n = 0; n < 2; ++n) *(f32x4*)(nk + (size_t)row * KVW + wc * 64 + 32 * bj + 16 * n + 4 * fq) = v[bj][n];
                }
                if (lat) {
#pragma unroll
                    for (int bj = 0; bj < 2; ++bj) { const int pos = bj ? (t & 63) : (t >> 6);
                        const f32x4* rp = (const f32x4*)(rope + (pos * 16 + 4 * fq) * 2); const f32x4 r0 = rp[0], r1 = rp[1];
                        const f32x4 cs = {r0[0], r0[2], r1[0], r1[2]}, sn = {r0[1], r0[3], r1[1], r1[3]};
                        const f32x4 x1 = v[bj][0], x2 = v[bj][1];
                        v[bj][0] = x1 * cs - x2 * sn; v[bj][1] = x2 * cs + x1 * sn; }
                }
                bf16_t* dst; float sc = 1.0f;
                if (isq) { dst = Q + (size_t)row * DM + (4 * u.pn + wc) * 64; sc = C2; }
                else dst = (lat ? KL + ((size_t)bl * KLROWS + PAST + t) * KVW : KC + (size_t)row * KVW) + wc * 64;
#pragma unroll
                for (int bj = 0; bj < 2; ++bj)
#pragma unroll
                    for (int n = 0; n < 2; ++n) { const f32x4 x = v[bj][n] * sc; u32x2 w; w.x = cvt_pk_bf16(x[0], x[1]); w.y = cvt_pk_bf16(x[2], x[3]);
                        *(u32x2*)(dst + 32 * bj + 16 * n + 4 * fq) = w; }
            }
    }
};
struct EpiGatesF { static constexpr bool PERM = true, AFTER_DRAIN = false; bf16_t* GA; bf16_t* GH;
    __device__ __forceinline__ void operator()(const f32x4 (&acc)[2][2][4][2], const Unit& u, int wr, int wc, int fr, int fq) const {
        const int row0 = u.pm * BM + wr * 64 + fr, col0 = (u.pn & 3) * BM + wc * 32 + 8 * fq; bf16_t* O = u.pn < 4 ? GA : GH;
#pragma unroll
        for (int ai = 0; ai < 2; ++ai)
#pragma unroll
            for (int m = 0; m < 4; ++m) { bf16_t* rowp = O + (size_t)(row0 + ai * HALF + m * 16) * DM + col0;
#pragma unroll
                for (int bj = 0; bj < 2; ++bj) { const f32x4 v0 = acc[ai][bj][m][0], v1 = acc[ai][bj][m][1];
                    u32x4 w; w.x = cvt_pk_bf16(sigm_f(v0[0]), sigm_f(v0[1])); w.y = cvt_pk_bf16(sigm_f(v0[2]), sigm_f(v0[3])); w.z = cvt_pk_bf16(sigm_f(v1[0]), sigm_f(v1[1])); w.w = cvt_pk_bf16(sigm_f(v1[2]), sigm_f(v1[3]));
                    *(u32x4*)(rowp + bj * HALF) = w; } }
    }
};
template <bool ADD, int MF> struct EpiGateMulF { static constexpr bool PERM = true, AFTER_DRAIN = false; const bf16_t* G; const bf16_t* P; bf16_t* O;
    __device__ __forceinline__ void operator()(const f32x4 (&acc)[2][2][MF][2], const Unit& u, int wr, int wc, int fr, int fq) const {
        const int row0 = u.pm * (64 * MF) + wr * (16 * MF) + fr, col0 = u.pn * BM + wc * 32 + 8 * fq;
#pragma unroll
        for (int ai = 0; ai < 2; ++ai)
#pragma unroll
            for (int m = 0; m < MF; ++m) { const size_t ro = (size_t)(row0 + ai * (32 * MF) + m * 16) * DM + col0;
#pragma unroll
                for (int bj = 0; bj < 2; ++bj) { const f32x4 v0 = acc[ai][bj][m][0], v1 = acc[ai][bj][m][1];
                    const u32x4 g = *(const u32x4*)(G + ro + bj * HALF);
                    float r[8] = {bflo(g.x) * v0[0], bfhi(g.x) * v0[1], bflo(g.y) * v0[2], bfhi(g.y) * v0[3], bflo(g.z) * v1[0], bfhi(g.z) * v1[1], bflo(g.w) * v1[2], bfhi(g.w) * v1[3]};
                    if (ADD) { const u32x4 p = *(const u32x4*)(P + ro + bj * HALF);
                        r[0] += bflo(p.x); r[1] += bfhi(p.x); r[2] += bflo(p.y); r[3] += bfhi(p.y); r[4] += bflo(p.z); r[5] += bfhi(p.z); r[6] += bflo(p.w); r[7] += bfhi(p.w); }
                    u32x4 w; w.x = cvt_pk_bf16(r[0], r[1]); w.y = cvt_pk_bf16(r[2], r[3]); w.z = cvt_pk_bf16(r[4], r[5]); w.w = cvt_pk_bf16(r[6], r[7]);
                    *(u32x4*)(O + ro + bj * HALF) = w; } }
    }
};
}

#include <hip/hip_bf16.h>
#include <cmath>
namespace attn_body {
using bf16=__hip_bfloat16;
using bf16x8=__attribute__((ext_vector_type(8)))short;
using s16x4=__attribute__((ext_vector_type(4)))short;
using f32x16=__attribute__((ext_vector_type(16)))float;
using u32x4=__attribute__((ext_vector_type(4)))unsigned;
constexpr int D=64,DM=1024,KVP=256;
constexpr int NW=8,QBLK=32,QB=QBLK*NW,KVBLK=64;
__device__ __forceinline__ int crow(int r,int hi){return (r&3)+8*(r>>2)+4*hi;}
#define SBAR() __builtin_amdgcn_sched_barrier(0)
__device__ __forceinline__ void wmask(f32x16&p0,f32x16&p1,int j,int kpos0,int qpos,int hi){
  const float NEG=-INFINITY; const int kb=kpos0+64*j+4*hi;
  #pragma unroll
  for(int r=0;r<16;++r){const int kp=kb+(r&3)+8*(r>>2),d0=kp-qpos,kq=kp+32,d1=kq-qpos;
    if(d0<-128||d0>128||kp<0||kp>=4096)p0[r]=NEG; if(d1<-128||d1>128||kq<0||kq>=4096)p1[r]=NEG;}
}

constexpr int NSLOT=3, SLOTB=8192;
constexpr int LDS_K=0, LDS_V=NSLOT*SLOTB, LDS_WS=2*NSLOT*SLOTB, LDS_OST=LDS_WS+NW*64*4, LDS_BYTES=LDS_OST+NW*4096;
constexpr float C2=0.125f*1.4426950408889634f;
__device__ __forceinline__ void glds16(const void*gsrc,unsigned lds_dst){unsigned keep;
  asm volatile("s_mov_b32 %0, m0\n\ts_mov_b32 m0, %2\n\ts_nop 0\n\tglobal_load_lds_dwordx4 %1, off\n\ts_mov_b32 m0, %0":"=&s"(keep):"v"(gsrc),"s"(lds_dst):"memory");}
__device__ __forceinline__ float max3f(float a,float b,float c){float r;asm("v_max3_f32 %0, %1, %2, %3":"=v"(r):"v"(a),"v"(b),"v"(c));return r;}
__device__ __forceinline__ float max2f(float a,float b){float r;asm("v_max_f32_e32 %0, %1, %2":"=v"(r):"v"(a),"v"(b));return r;}
__device__ __forceinline__ float fadd_s(float a,float b){float r;asm("v_add_f32_e32 %0, %1, %2":"=v"(r):"v"(a),"v"(b));return r;}
__device__ __forceinline__ float fsub_s(float a,float b){float r;asm("v_sub_f32_e32 %0, %1, %2":"=v"(r):"v"(a),"v"(b));return r;}
typedef float f32x2_t __attribute__((ext_vector_type(2))); typedef __bf16 bf16x2_t __attribute__((ext_vector_type(2)));
__device__ __forceinline__ unsigned cvtpk_s(float lo,float hi){f32x2_t v={lo,hi};bf16x2_t b=__builtin_convertvector(v,bf16x2_t);return __builtin_bit_cast(unsigned,b);}
#define WAIT_BAR(N) asm volatile("s_waitcnt vmcnt(" #N ") lgkmcnt(0)\n\ts_barrier":::"memory")

__device__ __forceinline__ void qkt(f32x16&p0,f32x16&p1,const char*Kslot,const bf16x8*qr,const f32x16&negm,int r32,int hi){
  const char*kb=Kslot+hi*1024+r32*16;
  #pragma unroll
  for(int d0=0;d0<4;++d0){
    const bf16x8 b0=*reinterpret_cast<const bf16x8*>(kb+d0*2048);
    const bf16x8 b1=*reinterpret_cast<const bf16x8*>(kb+d0*2048+512);
    if(d0==0){p0=__builtin_amdgcn_mfma_f32_32x32x16_bf16(b0,qr[0],negm,0,0,0);p1=__builtin_amdgcn_mfma_f32_32x32x16_bf16(b1,qr[0],negm,0,0,0);}
    else{p0=__builtin_amdgcn_mfma_f32_32x32x16_bf16(b0,qr[d0],p0,0,0,0);p1=__builtin_amdgcn_mfma_f32_32x32x16_bf16(b1,qr[d0],p1,0,0,0);}}
}
typedef __attribute__((address_space(3))) const char* lds_cptr;
typedef short v4i16_t __attribute__((ext_vector_type(4)));
__device__ __forceinline__ void kload8(bf16x8*kf,lds_cptr kp){
  kf[0]=*(const __attribute__((address_space(3))) bf16x8*)(kp);      kf[1]=*(const __attribute__((address_space(3))) bf16x8*)(kp+512);
  kf[2]=*(const __attribute__((address_space(3))) bf16x8*)(kp+2048); kf[3]=*(const __attribute__((address_space(3))) bf16x8*)(kp+2560);
  kf[4]=*(const __attribute__((address_space(3))) bf16x8*)(kp+4096); kf[5]=*(const __attribute__((address_space(3))) bf16x8*)(kp+4608);
  kf[6]=*(const __attribute__((address_space(3))) bf16x8*)(kp+6144); kf[7]=*(const __attribute__((address_space(3))) bf16x8*)(kp+6656);
}
__device__ __forceinline__ void kload2(bf16x8*kf,lds_cptr kp,int j){ kf[2*j]=*(const __attribute__((address_space(3))) bf16x8*)(kp+j*2048); kf[2*j+1]=*(const __attribute__((address_space(3))) bf16x8*)(kp+j*2048+512); }
__device__ __forceinline__ s16x4 vtr(lds_cptr p){ return __builtin_bit_cast(s16x4,__builtin_amdgcn_ds_read_tr16_b64_v4i16((__attribute__((address_space(3))) v4i16_t*)p)); }
__device__ __forceinline__ float rowmax(const f32x16&p0,const f32x16&p1){
  float a=max3f(p0[0],p0[1],p1[0]),b=max3f(p0[2],p0[3],p1[1]);a=max3f(a,p1[2],p1[3]);
  #pragma unroll
  for(int r=4;r<16;r+=4){a=max3f(a,p0[r],p0[r+1]);b=max3f(b,p0[r+2],p0[r+3]);a=max3f(a,p1[r],p1[r+1]);b=max3f(b,p1[r+2],p1[r+3]);}
  const float m=max2f(a,b);
  auto rr=__builtin_amdgcn_permlane32_swap(__float_as_uint(m),__float_as_uint(m),false,false);
  return max2f(__uint_as_float(rr[0]),__uint_as_float(rr[1]));
}
__device__ __forceinline__ void pv(f32x16*o,int vb,bf16x8 pa0,bf16x8 pa1,bf16x8 pa2,bf16x8 pa3){
  #pragma unroll
  for(int d0=0;d0<2;++d0){s16x4 lo[4],hi[4];
    #pragma unroll
    for(int ks=0;ks<4;++ks){
      asm volatile("ds_read_b64_tr_b16 %0,%1 offset:%c2":"=&v"(lo[ks]):"v"(vb),"i"(d0*4096+ks*1024):"memory");
      asm volatile("ds_read_b64_tr_b16 %0,%1 offset:%c2":"=&v"(hi[ks]):"v"(vb),"i"(d0*4096+ks*1024+512):"memory");}
    asm volatile("s_waitcnt lgkmcnt(0)":::"memory");SBAR();
    #define PK(k) (bf16x8){lo[k][0],lo[k][1],lo[k][2],lo[k][3],hi[k][0],hi[k][1],hi[k][2],hi[k][3]}
    o[d0]=__builtin_amdgcn_mfma_f32_32x32x16_bf16(pa0,PK(0),o[d0],0,0,0);
    o[d0]=__builtin_amdgcn_mfma_f32_32x32x16_bf16(pa1,PK(1),o[d0],0,0,0);
    o[d0]=__builtin_amdgcn_mfma_f32_32x32x16_bf16(pa2,PK(2),o[d0],0,0,0);
    o[d0]=__builtin_amdgcn_mfma_f32_32x32x16_bf16(pa3,PK(3),o[d0],0,0,0);
    #undef PK
  }
}

#ifndef ATTN_STORE16
#define ATTN_STORE16(p,v) (*(u32x4*)(p)=(v))
#endif
template<int THRL> __device__ __forceinline__ void attn_unit(long qrow0,int kvh,const bf16*__restrict__ Kb,const bf16*__restrict__ Vb,int NT,int woff,bool lat,int qpos0,const float*sinkp,const bf16*Q,bf16*O,char*shm,bool dry=false){
  const int tid=threadIdx.x,lane=tid&63,r32=lane&31,hi=lane>>5; const int wid=__builtin_amdgcn_readfirstlane(tid>>6);
  const int h=4*kvh+(wid&3), rowoff=(wid>>2)*QBLK;
  const float sinkl2=sinkp[h]*1.4426950408889634f;
  const bf16*Qw=Q+(qrow0+rowoff)*DM+h*D;
  const bf16*Kh=Kb+kvh*D,*Vh=Vb+kvh*D;
  const unsigned lds0=(unsigned)(uintptr_t)shm;
  float*wsf=(float*)(shm+LDS_WS)+wid*64;
  const bf16*ksrc=Kh+(long)lane*KVP+wid*8;
  const bf16*vsrc=Vh+(long)(16*(wid&3)+(lane>>2))*KVP+(wid>>2)*32+(lane&3)*8;
  const unsigned kdst=lds0+LDS_K+wid*1024, vdst=lds0+LDS_V+wid*1024;
  #define TROW(t) ((long)(t)*KVBLK+(((t)>=8)?woff:0))
  #define DMA_K(t,slot) glds16(ksrc+TROW(t)*KVP,(unsigned)__builtin_amdgcn_readfirstlane(kdst+(slot)))
  #define DMA_V(t,slot) glds16(vsrc+TROW(t)*KVP,(unsigned)__builtin_amdgcn_readfirstlane(vdst+(slot)))
  const int vb0=(int)(lds0+LDS_V)+((lane>>4)&1)*32+(lane&3)*8+(4*hi+((lane&15)>>2))*64;
  const char*Kbase=shm+LDS_K; bf16x8 kf[8];
  const lds_cptr shm3=(lds_cptr)shm; const lds_cptr kp0=shm3+LDS_K+hi*1024+r32*16; const lds_cptr vp0=shm3+LDS_V+((lane>>4)&1)*32+(lane&3)*8+(4*hi+((lane&15)>>2))*64;
  DMA_K(0,0);DMA_V(0,0);DMA_K(1,SLOTB);
  bf16x8 qr[4];
  #pragma unroll
  for(int d0=0;d0<4;++d0)qr[d0]=*reinterpret_cast<const bf16x8*>(&Qw[(long)r32*DM+d0*16+hi*8]);
  float mhat=0.f,l_reg=0.f;f32x16 o[2];o[0]=f32x16{};o[1]=f32x16{};f32x16 negm=f32x16{};asm volatile("":"+v"(negm));
  const int qpos=qpos0+rowoff+r32;
  #define CMASK(P0,P1,t) do{ if(lat&&(t)>=8)wmask(P0,P1,(t)-8,qpos0-128,qpos,hi); }while(0)
  bool resc=false;
  #define START(P0,P1) do{ const float rm=rowmax(P0,P1); resc=false; \
    { const float dl=rm; mhat=fadd_s(mhat,dl); \
      _Pragma("unroll") for(int r=0;r<16;++r){P0[r]=fsub_s(P0[r],dl);P1[r]=fsub_s(P1[r],dl);} \
      _Pragma("unroll") for(int r=0;r<16;++r)negm[r]=-mhat; asm volatile("":"+v"(negm)); } \
    _Pragma("unroll") for(int r=0;r<16;++r)P0[r]=__builtin_amdgcn_exp2f(P0[r]); }while(0)
  #define RESC() do{ if(resc){ asm volatile("s_waitcnt lgkmcnt(0)":::"memory"); \
      _Pragma("unroll") for(int d_=0;d_<2;++d_) _Pragma("unroll") for(int r=0;r<16;++r)o[d_][r]*=wsf[crow(r,hi)]; } }while(0)
  f32x16 pA0,pA1,pB0,pB1;
  int sl_prev=0,sl_cur=0,sl_next=SLOTB;
  #define ROT() do{sl_prev=sl_cur;sl_cur=sl_next;sl_next=(sl_next==(NSLOT-1)*SLOTB)?0:sl_next+SLOTB;}while(0)
  DMA_K(2,2*SLOTB);
  WAIT_BAR(3);
  qkt(pA0,pA1,Kbase,qr,negm,r32,hi);asm volatile("s_nop 15\n\ts_nop 7":"+v"(pA0),"+v"(pA1));CMASK(pA0,pA1,0);
  START(pA0,pA1);
  _Pragma("unroll") for(int r=0;r<16;++r)pA1[r]=__builtin_amdgcn_exp2f(pA1[r]);
  WAIT_BAR(0);
  DMA_K(3,0);DMA_V(1,SLOTB);
  ROT();
  kload8(kf,kp0+sl_cur);
  WAIT_BAR(2);
  s16x4 vlo[8],vhi[8]; u32x4 pw0,pw1,pw2,pw3;
  #define PKW(P,B) cvtpk_s(P[B],P[B+1])
  #define PAF(k) __builtin_bit_cast(bf16x8,pw##k)
  #define VFR(i) (bf16x8){vlo[i][0],vlo[i][1],vlo[i][2],vlo[i][3],vhi[i][0],vhi[i][1],vhi[i][2],vhi[i][3]}
  #define PIN(x) asm volatile("":"+v"(x))
  #define MX3(a,b,c) __builtin_fmaxf(__builtin_fmaxf((a),(b)),(c))
  #define GAPA(MF,A0,A1,A2,A3,W0,W1,PW) do{ MF; sacc+=A0; sacc+=A1; sacc+=A2; sacc+=A3; PIN(sacc); W0; W1; PIN(PW); SBAR(); }while(0)
  #define EX(v) __builtin_amdgcn_exp2f(v)
  #define GAPB(MF,X,B) do{ MF; X[B]=EX(X[B]); X[B+1]=EX(X[B+1]); X[B+2]=EX(X[B+2]); X[B+3]=EX(X[B+3]); PIN(X); SBAR(); }while(0)
  #define VRD(i) do{ vlo[i]=vtr(vp_+(((i)>>2)*4096+((i)&3)*1024)); vhi[i]=vtr(vp_+(((i)>>2)*4096+((i)&3)*1024+512)); }while(0)
  #define KRD(G,j) do{ if(G){ kload2(kf,kp0+sl_next,j); SBAR(); } }while(0)
  #define STEP(C0,C1,P0,P1,t,GK,GV,GL) do{ SBAR(); \
    const lds_cptr vp_=vp0+sl_prev; \
    VRD(0); SBAR(); float sacc=(P0[0]+P0[1]); \
    GAPA(C0=__builtin_amdgcn_mfma_f32_32x32x16_bf16(kf[0],qr[0],negm,0,0,0), P0[2],P0[3],P0[4],P0[5],     pw0[0]=PKW(P0,0), pw0[1]=PKW(P0,2), pw0); \
    VRD(4); SBAR(); GAPA(C1=__builtin_amdgcn_mfma_f32_32x32x16_bf16(kf[1],qr[0],negm,0,0,0), P0[6],P0[7],P0[8],P0[9],     pw0[2]=PKW(P0,4), pw0[3]=PKW(P0,6), pw0); \
    VRD(1); SBAR(); GAPA(C0=__builtin_amdgcn_mfma_f32_32x32x16_bf16(kf[2],qr[1],C0,0,0,0),   P0[10],P0[11],P0[12],P0[13], pw1[0]=PKW(P0,8), pw1[1]=PKW(P0,10), pw1); \
    VRD(5); SBAR(); GAPA(C1=__builtin_amdgcn_mfma_f32_32x32x16_bf16(kf[3],qr[1],C1,0,0,0),   P0[14],P0[15],P1[0],P1[1],   pw1[2]=PKW(P0,12),pw1[3]=PKW(P0,14), pw1); \
    VRD(2); SBAR(); GAPA(C0=__builtin_amdgcn_mfma_f32_32x32x16_bf16(kf[4],qr[2],C0,0,0,0),   P1[2],P1[3],P1[4],P1[5],     pw2[0]=PKW(P1,0), pw2[1]=PKW(P1,2), pw2); \
    VRD(6); SBAR(); GAPA(C1=__builtin_amdgcn_mfma_f32_32x32x16_bf16(kf[5],qr[2],C1,0,0,0),   P1[6],P1[7],P1[8],P1[9],     pw2[2]=PKW(P1,4), pw2[3]=PKW(P1,6), pw2); \
    VRD(3); SBAR(); GAPA(C0=__builtin_amdgcn_mfma_f32_32x32x16_bf16(kf[6],qr[3],C0,0,0,0),   P1[10],P1[11],P1[12],P1[13], pw3[0]=PKW(P1,8), pw3[1]=PKW(P1,10), pw3); \
    VRD(7); SBAR(); GAPA(C1=__builtin_amdgcn_mfma_f32_32x32x16_bf16(kf[7],qr[3],C1,0,0,0),   P1[14],P1[15],0.f,0.f,       pw3[2]=PKW(P1,12),pw3[3]=PKW(P1,14), pw3); \
    l_reg+=sacc; \
    if(GK){DMA_K((t)+3,sl_cur);} if(GV){DMA_V((t)+1,sl_next);} \
    CMASK(C0,C1,t); \
    { float a=MX3(C0[0],C0[1],C1[0]),b=MX3(C0[2],C0[3],C1[1]); a=MX3(a,C1[2],C1[3]); \
      _Pragma("unroll") for(int r=4;r<16;r+=4){a=MX3(a,C0[r],C0[r+1]);b=MX3(b,C0[r+2],C0[r+3]);a=MX3(a,C1[r],C1[r+1]);b=MX3(b,C1[r+2],C1[r+3]);} \
      float rm=__builtin_fmaxf(a,b); { auto rr=__builtin_amdgcn_permlane32_swap(__float_as_uint(rm),__float_as_uint(rm),false,false); rm=__builtin_fmaxf(__uint_as_float(rr[0]),__uint_as_float(rr[1])); } \
      resc=false; \
      if(__builtin_expect(__any(rm>(float)THRL),0)){ const float dl=__builtin_fmaxf(rm,0.f); mhat+=dl; \
        _Pragma("unroll") for(int r=0;r<16;++r){C0[r]-=dl;C1[r]-=dl;} \
        _Pragma("unroll") for(int r=0;r<16;++r)negm[r]=-mhat; asm volatile("":"+v"(negm)); \
        const float f=__builtin_amdgcn_exp2f(-dl); l_reg*=f; if(hi==0)wsf[r32]=f; resc=true; } } \
    SBAR(); \
    GAPB(o[0]=__builtin_amdgcn_mfma_f32_32x32x16_bf16(PAF(0),VFR(0),o[0],0,0,0), C0,0); \
    GAPB(o[1]=__builtin_amdgcn_mfma_f32_32x32x16_bf16(PAF(0),VFR(4),o[1],0,0,0), C0,4); \
    KRD(GL,0); GAPB(o[0]=__builtin_amdgcn_mfma_f32_32x32x16_bf16(PAF(1),VFR(1),o[0],0,0,0), C0,8); \
    KRD(GL,1); GAPB(o[1]=__builtin_amdgcn_mfma_f32_32x32x16_bf16(PAF(1),VFR(5),o[1],0,0,0), C0,12); \
    KRD(GL,2); GAPB(o[0]=__builtin_amdgcn_mfma_f32_32x32x16_bf16(PAF(2),VFR(2),o[0],0,0,0), C1,0); \
    KRD(GL,3); GAPB(o[1]=__builtin_amdgcn_mfma_f32_32x32x16_bf16(PAF(2),VFR(6),o[1],0,0,0), C1,4); \
    GAPB(o[0]=__builtin_amdgcn_mfma_f32_32x32x16_bf16(PAF(3),VFR(3),o[0],0,0,0), C1,8); \
    GAPB(o[1]=__builtin_amdgcn_mfma_f32_32x32x16_bf16(PAF(3),VFR(7),o[1],0,0,0), C1,12); \
    }while(0)
  int t=1;
  #undef CMASK
  #define CMASK(P0,P1,t) do{}while(0)
  for(;t+5<NT&&t+1<8;t+=2){
    STEP(pB0,pB1,pA0,pA1,t,true,true,true);     WAIT_BAR(2); RESC(); ROT();
    STEP(pA0,pA1,pB0,pB1,t+1,true,true,true);   WAIT_BAR(2); RESC(); ROT();
  }
  #undef CMASK
  #define CMASK(P0,P1,t) do{ if(lat&&(t)>=8)wmask(P0,P1,(t)-8,qpos0-128,qpos,hi); }while(0)
  #define ENDW(tt) do{ if((tt)+3<NT){WAIT_BAR(2);} else if((tt)+2<NT){WAIT_BAR(1);} else {WAIT_BAR(0);} }while(0)
  for(;t+2<NT;t+=2){
    STEP(pB0,pB1,pA0,pA1,t,(t+3<NT),(t+1<NT),(t+1<NT));       ENDW(t);   RESC(); ROT();
    STEP(pA0,pA1,pB0,pB1,t+1,(t+4<NT),(t+2<NT),(t+2<NT));     ENDW(t+1); RESC(); ROT();
  }
  #define DRAIN(P0,P1) do{ float sacc=P0[0]+P0[1]; _Pragma("unroll") for(int r=2;r<16;++r)sacc+=P0[r]; _Pragma("unroll") for(int r=0;r<16;++r)sacc+=P1[r]; l_reg+=sacc; \
    pw0=(u32x4){PKW(P0,0),PKW(P0,2),PKW(P0,4),PKW(P0,6)};pw1=(u32x4){PKW(P0,8),PKW(P0,10),PKW(P0,12),PKW(P0,14)};pw2=(u32x4){PKW(P1,0),PKW(P1,2),PKW(P1,4),PKW(P1,6)};pw3=(u32x4){PKW(P1,8),PKW(P1,10),PKW(P1,12),PKW(P1,14)}; \
    SBAR(); pv(o,vb0+sl_cur,PAF(0),PAF(1),PAF(2),PAF(3)); }while(0)
  if(NT&1){
    STEP(pB0,pB1,pA0,pA1,t,(t+3<NT),(t+1<NT),(t+1<NT));       ENDW(t);   RESC(); ROT();
    STEP(pA0,pA1,pB0,pB1,NT-1,false,false,false); RESC();
    DRAIN(pA0,pA1);
  }else{
    STEP(pB0,pB1,pA0,pA1,NT-1,false,false,false); RESC();
    DRAIN(pB0,pB1);
  }
  #undef DRAIN
  #undef PKW
  #undef PAF
  #undef VFR
  #undef PIN
  #undef MX3
  #undef GAPA
  #undef GAPB
  #undef EX
  #undef VRD
  #undef KRD
  #undef STEP
  #undef ENDW
  {auto rr=__builtin_amdgcn_permlane32_swap(__float_as_uint(l_reg),__float_as_uint(l_reg),false,false);l_reg=__uint_as_float(rr[0])+__uint_as_float(rr[1]);}
  l_reg+=__builtin_amdgcn_exp2f(sinkl2-mhat);
  if(hi==0)wsf[32+r32]=l_reg;asm volatile("s_waitcnt lgkmcnt(0)":::"memory");
  float rli[16];
  #pragma unroll
  for(int r=0;r<16;++r)rli[r]=__builtin_amdgcn_rcpf(wsf[32+crow(r,hi)]);
  bf16*Ow=O+(qrow0+rowoff)*DM+h*D;
  { bf16*stg=(bf16*)(shm+LDS_OST)+wid*2048;
    #pragma unroll
    for(int r=0;r<16;++r){const int orow=crow(r,hi);
      #pragma unroll
      for(int d0=0;d0<2;++d0)stg[orow*64+d0*32+r32]=__float2bfloat16(o[d0][r]*rli[r]);}
    asm volatile("s_waitcnt lgkmcnt(0)":::"memory");
    #pragma unroll
    for(int i=0;i<4;++i){const int row=i*8+(lane>>3),ch=lane&7; const u32x4 v=*(const u32x4*)(stg+row*64+ch*8); if(!dry)ATTN_STORE16(Ow+(long)row*DM+ch*8,v);} }
  asm volatile("s_waitcnt lgkmcnt(0)\n\ts_barrier":::"memory");
  #undef TROW
  #undef DMA_K
  #undef DMA_V
  #undef CMASK
  #undef START
  #undef RESC
  #undef ROT
}
#undef SBAR
#undef WAIT_BAR
}

__device__ __forceinline__ void attn_fast(const Args& args, Frame& F, unsigned char* ldsg, bool dry = false) {
    typedef attn_body::bf16 abf;
    const abf* Q = (const abf*)WSP(bf16, WS_Q);
    for (int i = F.bid; i < 2048 + 256; i += F.G) {
        if (i < 2048) { const int qb = i & 63, kvh = (i >> 6) & 3, bl = i >> 8;
            attn_body::attn_unit<8>((long)NCTX + (long)bl * LSEQ + qb * 64, kvh, (const abf*)(WSP(bf16, WS_KL) + (size_t)bl * KLROWS * KVW), (const abf*)(WSP(bf16, WS_VL) + (size_t)bl * KLROWS * KVW),
                                    13, 64 * qb - 128, true, 64 * qb, args.in[I_SINK], Q, (abf*)Q, (char*)ldsg, dry); }
        else { const int j = i - 2048, qb = j & 3, kvh = (j >> 2) & 3, bc = j >> 4;
            attn_body::attn_unit<8>((long)bc * CSEQ + qb * 64, kvh, (const abf*)(WSP(bf16, WS_KC) + (size_t)bc * CSEQ * KVW), (const abf*)(WSP(bf16, WS_VC) + (size_t)bc * CSEQ * KVW),
                                    4, 0, false, 0, args.in[I_SINK], Q, (abf*)Q, (char*)ldsg, dry); }
    }
}

#define XB_TMO      128
#define XB_XCNT(j)  (256  + 64 * (j))
#define XB_XSUB(j)  (1280 + 64 * (j))
#define XB_XGEN(j)  (2304 + 64 * (j))
#define XB_TOP      3328
#define XB_TOPGEN   3392
#define XCD_BAR_WORDS 3456
#define XB_SPIN_CAP (1u << 24)
__device__ __forceinline__ unsigned xb_ld(unsigned* p)              { return __hip_atomic_load(p, __ATOMIC_RELAXED, __HIP_MEMORY_SCOPE_AGENT); }
__device__ __forceinline__ unsigned xb_add(unsigned* p, unsigned v) { return __hip_atomic_fetch_add(p, v, __ATOMIC_RELAXED, __HIP_MEMORY_SCOPE_AGENT); }
__device__ __forceinline__ unsigned xb_xcc_id() { return (unsigned)__builtin_amdgcn_s_getreg((3 << 11) | 20) & 0xFu; }
#define XB_SPIN(cond, bar) do { unsigned _sp = 0; while (cond) { __builtin_amdgcn_s_sleep(1); \
    if ((++_sp & 255u) == 0u) { if (xb_ld(&(bar)[XB_TMO])) break; if (_sp > XB_SPIN_CAP) { atomicAdd(&(bar)[XB_TMO], 1u); break; } } } } while (0)
struct XcdBarrier { unsigned* bar; unsigned x; volatile LAS unsigned* st; };
__device__ __forceinline__ XcdBarrier xcd_barrier_post(unsigned* bar, volatile LAS unsigned* st) {
    XcdBarrier b; b.bar = bar; b.x = xb_xcc_id(); b.st = st;
    if (threadIdx.x == 0) (void)xb_add(&bar[XB_XCNT(b.x)], 1u);
    return b;
}
__device__ __forceinline__ void xcd_barrier_complete(unsigned* bar, unsigned x, unsigned& nloc, unsigned& nx) {
    const unsigned G = gridDim.x * gridDim.y * gridDim.z;
    unsigned sum, cnt, mine, sp = 0u;
    for (;;) {
        sum = 0u; cnt = 0u; mine = 0u;
#pragma unroll
        for (unsigned j = 0; j < 16; ++j) { const unsigned c = xb_ld(&bar[XB_XCNT(j)]); sum += c; cnt += (c > 0u) ? 1u : 0u; mine = (j == x) ? c : mine; }
        if (sum == G) break;
        __builtin_amdgcn_s_sleep(1);
        if ((++sp & 255u) == 0u) { if (xb_ld(&bar[XB_TMO])) break; if (sp > XB_SPIN_CAP) { atomicAdd(&bar[XB_TMO], 1u); break; } }
    }
    nloc = mine > 0u ? mine : 1u; nx = cnt > 0u ? cnt : 1u;
}
__device__ __forceinline__ void xcd_barrier(const XcdBarrier& b) {
    asm volatile("s_waitcnt vmcnt(0)" ::: "memory");
    __syncthreads();
    if (threadIdx.x == 0) {
        unsigned* bar = b.bar;
        __builtin_amdgcn_s_waitcnt(0);
        unsigned nloc = b.st[0], nx = b.st[1];
        if (nloc == 0u) { xcd_barrier_complete(bar, b.x, nloc, nx); b.st[0] = nloc; b.st[1] = nx; }
        const unsigned bk_ = b.st[2];
        const unsigned old = xb_add(&bar[XB_XSUB(b.x)], 1u);
        const unsigned gen = old / nloc;
        if (old + 1u == (gen + 1u) * nloc) {
            __builtin_amdgcn_fence(__ATOMIC_RELEASE, "agent");
            asm volatile("s_waitcnt vmcnt(0)" ::: "memory");
            (void)xb_add(&bar[XB_TOP], 1u);
            { const unsigned target = (b.st[2] + 1u) * nx; XB_SPIN(xb_ld(&bar[XB_TOP]) < target, bar); }
            xb_add(&bar[XB_XGEN(b.x)], 1u);
            __builtin_amdgcn_fence(__ATOMIC_ACQUIRE, "agent");
            asm volatile("s_waitcnt vmcnt(0)" ::: "memory");
        } else {
            XB_SPIN(xb_ld(&bar[XB_XGEN(b.x)]) == gen, bar);
            __builtin_amdgcn_fence(__ATOMIC_ACQUIRE, "agent");
            asm volatile("s_waitcnt vmcnt(0)" ::: "memory");
        }
        b.st[2] = bk_ + 1u;
    }
    __syncthreads();
}

constexpr int NPHASE = 15;
constexpr int CW_BAR = 4096;
__global__ void __launch_bounds__(NTHR, 2) mega(Args args) {
    extern __shared__ __attribute__((aligned(16))) unsigned char lds[];
    Frame F;
    F.lds = (LAS unsigned char*)lds; F.tid = threadIdx.x; F.lane = F.tid & 63; F.wave = __builtin_amdgcn_readfirstlane(F.tid >> 6);
    F.G = gridDim.x; F.bid = blockIdx.x; F.out = args.out; F.ws = args.ws;
    volatile LAS unsigned* MISC = (volatile LAS unsigned*)(F.lds + LDS_BYTES - 64);
    if (F.tid < 16) MISC[F.tid] = 0u;
    __syncthreads();
    XcdBarrier bar; bar.bar = (unsigned*)(F.ws + WS_CTL) + CW_BAR; bar.x = 0; bar.st = nullptr;
    if (MK_ONE_LAUNCH) bar = xcd_barrier_post((unsigned*)(F.ws + WS_CTL) + CW_BAR, MISC + 8);
    const int lo = args.ph_lo, hi = args.ph_hi;
#define IN(k) (lo <= (k) && (k) < hi)
#define REP(k) for (int rep_ = 0; rep_ < 1 + (((REPMASK) >> (k)) & 1); ++rep_)
#define SEAM(k) do { if (IN(k) && IN((k) + 1)) xcd_barrier(bar); } while (0)
    const float* MOD = WSP(float, WS_MOD);
    typedef pg8::EpiResB3<0, false> EpiRes3In; typedef pg8::EpiResB3<1, false> EpiRes3Mid; typedef pg8::EpiResB3<1, true> EpiRes3Out;
    bf16* GA_ = (bf16*)F.out + (size_t)MTOK * DM;
    bf16* X1 = (bf16*)F.out; bf16* X2 = WSP(bf16, WS_A);
 typedef pg8::EpiGateMulF<false, 3> EpiMul; typedef pg8::EpiGateMulF<true, 3> EpiMulAdd;
#define GEMM_PHASE(EPI_T, Aptr, Bptr, M_, N_, K_, ...) do { pg8::Gemm g_{Aptr, Bptr, M_, N_, K_}; pg8::StaticOrder S_; S_.init(M_, N_, F.G, F.bid); \
        EPI_T E_{__VA_ARGS__}; pg8::gemm_phase<EPI_T, pg8::StaticOrder, true, true>(F.lds, g_, S_, E_); } while (0)
    if (IN(0)) REP(0) { p0_mod(args, F, 0, 64, 0); __syncthreads(); p0_weights(args, F, 0, 0); }
    SEAM(0);
    if (IN(1)) REP(1) { norm_rows(args, F, 0, WSP(bf16, WS_A)); } SEAM(1);
#define GEMM_PHASE3(EPI_T, Aptr, Bptr, M_, N_, K_, ...) do { pg8::Gemm g_{Aptr, Bptr, M_, N_, K_}; pg8::StaticOrder S_; S_.init(M_, N_, F.G, F.bid, 192); \
        EPI_T E_{__VA_ARGS__}; pg8::gemm_phase<EPI_T, pg8::StaticOrder, true, true, 3>(F.lds, g_, S_, E_); } while (0)
#define FG(k) (((FASTMASK) >> (k)) & 1)
    if (IN(2)) REP(2) { if (FG(2)) GEMM_PHASE(pg8::EpiSwigluF, WSP(bf16, WS_A), WSP(bf16, WS_WI1), MTOK, 2 * DFF, DM, WSP(bf16, WS_U));
                 else sgemm<2>(args, F, WSP(bf16, WS_A), WSP(bf16, WS_WI1), MTOK, DFF, DM, RmGate{}, RmUp{}, EpiSwiglu{WSP(bf16, WS_U)}); }
    if (IN(2)) { __syncthreads(); const int c0_ = F.G > 96 ? 96 : 0; p0_weights(args, F, 1, c0_); __syncthreads(); p0_mod(args, F, 64, MODW / 32, c0_); p0_h2(args, F, c0_);
        if (F.bid >= c0_) for (int i = (F.bid - c0_) * NTHR + F.tid; i < 1024; i += (F.G - c0_) * NTHR) { const float ang = (float)(i >> 4) * powf(10000.0f, -(float)(i & 15) / 16.0f); WSP(float, WS_ROPE)[2 * i] = cosf(ang); WSP(float, WS_ROPE)[2 * i + 1] = sinf(ang); } }
    SEAM(2);
    if (IN(3)) REP(3) { GEMM_PHASE3(EpiRes3In, WSP(bf16, WS_U), WSP(bf16, WS_WO1), MTOK, DM, DFF, args.in[I_XP], args.in[I_XS], nullptr, X1, nullptr, MOD, 2 * DM, 0.5f); } SEAM(3);
    if (IN(4)) REP(4) { norm_rows_b(args, F, 1, X1, WSP(bf16, WS_A)); } SEAM(4);
    if (IN(5)) REP(5) { if (FG(5)) GEMM_PHASE(pg8::EpiQKVF, WSP(bf16, WS_A), WSP(bf16, WS_WQKV), MTOK, NQKV, DM, WSP(bf16, WS_Q), WSP(bf16, WS_KC), WSP(bf16, WS_KL), WSP(bf16, WS_VC), WSP(bf16, WS_VL),
                            F.out + OUT_NK, F.out + OUT_NV, args.in[I_QN], args.in[I_KN], WSP(float, WS_ROPE));
                 else qkv_naive(args, F);
                 if (FG(6)) GEMM_PHASE(pg8::EpiBf16P, WSP(bf16, WS_WHY), WSP(bf16, WS_A), NHY, MTOK, DM, WSP(bf16, WS_HYT), MTOK);
                 else sgemm<1>(args, F, WSP(bf16, WS_WHY), WSP(bf16, WS_A), NHY, MTOK, DM, RmId{}, RmId{}, EpiHyT{WSP(bf16, WS_HYT)}); }
    if (IN(5)) { __syncthreads(); const int c0_ = F.G > 96 ? 96 : 0;
                 p1_taps(args, F, c0_); cache_rows(args, F, c0_); }
    SEAM(5);
    if (IN(6)) {
#if FAST_ATTN
        if (DRY_AT) { attn_fast(args, F, lds, args.pad == 0); __syncthreads(); }
        attn_fast(args, F, lds); __syncthreads();
#else
        attn_naive(args, F);
#endif
#if FAST_HYENA
#if HY_FFT
        if (DRY_HY) { hyena_fft(args, F, args.pad == 0); __syncthreads(); hyena_fast<false>(args, F, args.pad == 0); }
#else
        if (DRY_HY) { hyena_fast<true>(args, F, args.pad == 0); hyena_fast<false>(args, F, args.pad == 0); }
#endif
#if HY_FFT
        hyena_fft(args, F); __syncthreads(); hyena_fast<false>(args, F);
#else
        hyena_fast<true>(args, F); hyena_fast<false>(args, F);
#endif
#else
        hyena_naive(args, F);
#endif
    } SEAM(6);
    if (IN(7)) REP(7) { hy_transpose(args, F); __syncthreads(); }
    if (IN(8)) REP(8) { if (FG(8)) GEMM_PHASE(pg8::EpiGatesF, WSP(bf16, WS_A), WSP(bf16, WS_WG), MTOK, NGATE, DM, GA_, WSP(bf16, WS_GH));
                 else sgemm<1>(args, F, WSP(bf16, WS_A), WSP(bf16, WS_WG), MTOK, NGATE, DM, RmId{}, RmId{}, EpiGates{GA_, WSP(bf16, WS_GH)}); } SEAM(8);
    if (IN(9)) REP(9) { if (FG(9)) GEMM_PHASE3(EpiMul, WSP(bf16, WS_Q), WSP(bf16, WS_WA), MTOK, DM, DM, GA_, nullptr, WSP(bf16, WS_MA));
                 else sgemm<1>(args, F, WSP(bf16, WS_Q), WSP(bf16, WS_WA), MTOK, DM, DM, RmId{}, RmId{}, EpiMA{GA_, WSP(bf16, WS_MA)}); }
    if (IN(10)) REP(10) { if (FG(10)) GEMM_PHASE3(EpiMulAdd, WSP(bf16, WS_HYO), WSP(bf16, WS_WH), MTOK, DM, DM, WSP(bf16, WS_GH), WSP(bf16, WS_MA), GA_);
                  else sgemm<1>(args, F, WSP(bf16, WS_HYO), WSP(bf16, WS_WH), MTOK, DM, DM, RmId{}, RmId{}, EpiMerged{WSP(bf16, WS_GH), WSP(bf16, WS_MA), GA_}); } SEAM(10);
    if (IN(11)) REP(11) { GEMM_PHASE3(EpiRes3Mid, GA_, WSP(bf16, WS_WOUT), MTOK, DM, DM, nullptr, nullptr, X1, X2, nullptr, MOD, 5 * DM, 1.0f); } SEAM(11);
    if (IN(12)) REP(12) { norm_rows_b(args, F, 2, X2, WSP(bf16, WS_A3)); } SEAM(12);
    if (IN(13)) REP(13) { if (FG(13)) GEMM_PHASE(pg8::EpiSwigluF, WSP(bf16, WS_A3), WSP(bf16, WS_WI2), MTOK, 2 * DFF, DM, WSP(bf16, WS_U));
                  else sgemm<2>(args, F, WSP(bf16, WS_A3), WSP(bf16, WS_WI2), MTOK, DFF, DM, RmGate{}, RmUp{}, EpiSwiglu{WSP(bf16, WS_U)}); } SEAM(13);
    if (IN(14)) REP(14) { GEMM_PHASE3(EpiRes3Out, WSP(bf16, WS_U), WSP(bf16, WS_WO2), MTOK, DM, DFF, nullptr, nullptr, X2, nullptr, F.out, MOD, 8 * DM, 0.5f); }
#undef IN
#undef SEAM
}

extern "C" void kernel_launch(void* const* d_in, const int* in_sizes, int n_in, void* d_out, int out_size, void* d_ws, size_t ws_size, hipStream_t stream) {
    static int grid = 0;
    if (grid == 0) {
        if (n_in != 33 || ws_size < WS_END) { fprintf(stderr, "kernel_launch: unexpected n_in %d / ws %zu\n", n_in, ws_size); grid = -1; return; }
        int dev = 0, cus = 0;
        if (hipGetDevice(&dev) != hipSuccess || hipDeviceGetAttribute(&cus, hipDeviceAttributeMultiprocessorCount, dev) != hipSuccess) { grid = -1; return; }
        if (hipFuncSetAttribute((const void*)mega, hipFuncAttributeMaxDynamicSharedMemorySize, LDS_BYTES) != hipSuccess) { fprintf(stderr, "kernel_launch: hipFuncSetAttribute failed\n"); grid = -1; return; }
        int per_cu = 0;
        if (hipOccupancyMaxActiveBlocksPerMultiprocessor(&per_cu, (const void*)mega, NTHR, LDS_BYTES) != hipSuccess || per_cu < 1) { fprintf(stderr, "kernel_launch: occupancy query reports %d workgroups per CU; nothing launched\n", per_cu); grid = -1; (void)hipGetLastError(); return; }
        (void)hipGetLastError();
        grid = cus;
    }
    if (grid < 0) return;
    (void)hipMemsetAsync((char*)d_ws + WS_CTL, 0, CTL_ZERO_BYTES, stream);
    Args a{};
    for (int i = 0; i < 33; ++i) a.in[i] = (const float*)d_in[i];
    a.out = (float*)d_out; a.ws = (unsigned char*)d_ws;
    if (MK_ONE_LAUNCH) { a.ph_lo = 0; a.ph_hi = NPHASE; a.li = 0; hipLaunchKernelGGL(mega, dim3(grid), dim3(NTHR), LDS_BYTES, stream, a); }
    else for (int p = 0; p < NPHASE; ++p) { a.ph_lo = p; a.ph_hi = p + 1; a.li = p; hipLaunchKernelGGL(mega, dim3(grid), dim3(NTHR), LDS_BYTES, stream, a); }
}
```
